# Optimizing an MI355X kernel written in HIP

```python
import math
import jax, jax.numpy as jnp
from jax import lax
import numpy as np


D_MODEL = 1024
BATCH = 8
SEQ = 4096
DEPTH = 4

GRID_W = 64
CTX_LEN = 256
D_MIX = D_MODEL
BRANCH_W = D_MIX // 2
A_HEADS = 8
A_QK = BRANCH_W // (2 * A_HEADS)
A_V = 2 * A_QK
CONV_W = 3
C_HEADS = 8
C_HEAD_DIM = BRANCH_W // C_HEADS
NA_KH = 8
NA_KW = 16
D_GROUPS = 8
D_GROUP_W = BRANCH_W // D_GROUPS
Q_BLOCK = 128
ROPE_BASE = 10000.0
EPS = 1e-6
N_EVEN = (DEPTH + 1) // 2
N_ODD = DEPTH // 2
EVEN_IN = 8 * BRANCH_W
ODD_IN = 6 * BRANCH_W

kernel_name = 'hybrid_diffusion_backbone'


def rms_norm(x, g):
    xf = x.astype(jnp.float32)
    y = xf * lax.rsqrt(jnp.mean(xf * xf, axis=-1, keepdims=True) + EPS)
    return (y * g.astype(jnp.float32)).astype(x.dtype)


def lambda_init(layer):
    return 0.8 - 0.6 * math.exp(-0.3 * layer)


def axial_rope(x, row, col):
    half = x.shape[-1] // 2
    nf = half // 2
    inv_freq = ROPE_BASE ** (-jnp.arange(nf, dtype=jnp.float32) / nf)

    def rotate(u, pos):
        ang = pos.astype(jnp.float32)[:, None] * inv_freq
        cos = jnp.cos(ang)[None, :, None, None, :]
        sin = jnp.sin(ang)[None, :, None, None, :]
        u1, u2 = u[..., :nf], u[..., nf:]
        return jnp.concatenate([u1 * cos - u2 * sin, u2 * cos + u1 * sin], axis=-1)

    xf = x.astype(jnp.float32)
    y = jnp.concatenate([rotate(xf[..., :half], row), rotate(xf[..., half:], col)], axis=-1)
    return y.astype(x.dtype)


def diff_attend(q, k, v, lam):
    s = jnp.einsum('bqhmd,bkhmd->bhmqk', q, k).astype(jnp.float32) * (A_QK ** -0.5)
    p = jax.nn.softmax(s, axis=-1)
    a = p[:, :, 0] - lam * p[:, :, 1]
    return jnp.einsum('bhqk,bkhd->bqhd', a, v.astype(jnp.float32))


def diff_attention_post(o, subln, lam_init):
    B, N = o.shape[:2]
    return (rms_norm(o, subln) * (1.0 - lam_init)).reshape(B, N, BRANCH_W)


def short_conv(b, c, u, w):
    z = c * u
    y = lax.conv_general_dilated(z, w.reshape(CONV_W, 1, BRANCH_W).astype(z.dtype),
                                 window_strides=(1,), padding='SAME',
                                 dimension_numbers=('NWC', 'WIO', 'NWC'),
                                 feature_group_count=BRANCH_W)
    return b * y


def fourier_mix(u):
    B, N, _ = u.shape
    ug = u.astype(jnp.float32).reshape(B, N, D_GROUPS, D_GROUP_W)
    y = jnp.fft.fft2(ug, axes=(1, 3), norm='ortho').real
    return y.reshape(B, N, BRANCH_W).astype(u.dtype)


def dense_attend(q, k, v):
    s = jnp.einsum('bqhd,bkhd->bhqk', q, k).astype(jnp.float32) * (C_HEAD_DIM ** -0.5)
    p = jax.nn.softmax(s, axis=-1)
    return jnp.einsum('bhqk,bkhd->bqhd', p, v.astype(jnp.float32))


def neighbourhood_attention(q, k, v, k_c, v_c, rpb):
    B, S, H, d = q.shape
    rows = S // GRID_W
    kh = min(NA_KH, rows)
    kw = NA_KW
    r = jnp.arange(rows)
    cq = jnp.arange(GRID_W)
    rs = jnp.clip(r - kh // 2, 0, rows - kh)
    cs = jnp.clip(cq - kw // 2, 0, GRID_W - kw)
    col_idx = cs[:, None] + jnp.arange(kw)[None, :]
    row_off = rs[:, None] + jnp.arange(kh)[None, :] - r[:, None] + (NA_KH - 1)
    col_off = col_idx - cq[:, None] + (NA_KW - 1)
    scale = d ** -0.5
    qg = jnp.moveaxis(q.reshape(B, rows, GRID_W, H, d), 1, 0)
    kg = k.reshape(B, rows, GRID_W, H, d)
    vg = v.reshape(B, rows, GRID_W, H, d)
    s_c_all = None

    def one_row(args):
        q_r, r0, roff = args
        kb = lax.dynamic_slice_in_dim(kg, r0, kh, axis=1)
        vb = lax.dynamic_slice_in_dim(vg, r0, kh, axis=1)
        kwin = kb[:, :, col_idx]
        vwin = vb[:, :, col_idx]
        bias = rpb[:, roff][:, :, col_off]
        s_w = jnp.einsum('bqhd,biqjhd->bhqij', q_r, kwin).astype(jnp.float32) * scale
        s_w = s_w + jnp.transpose(bias, (0, 2, 1, 3))[None].astype(jnp.float32)
        s_w = s_w.reshape(B, H, GRID_W, kh * kw)
        s_c = jnp.einsum('bqhd,bkhd->bhqk', q_r, k_c).astype(jnp.float32) * scale
        p = jax.nn.softmax(jnp.concatenate([s_w, s_c], axis=-1), axis=-1)
        p_w = p[..., :kh * kw].reshape(B, H, GRID_W, kh, kw)
        p_c = p[..., kh * kw:]
        return (jnp.einsum('bhqij,biqjhd->bqhd', p_w, vwin.astype(jnp.float32))
                + jnp.einsum('bhqk,bkhd->bqhd', p_c, v_c.astype(jnp.float32)))

    o = lax.map(one_row, (qg, rs, row_off))
    return jnp.moveaxis(o, 0, 1).reshape(B, S, H * d)


def even_mixer(px, pc, lam_p, subln, conv_w, lam_init, row, col, need_ctx):
    B, S, _ = px.shape
    L = pc.shape[1]
    qa, ka, va, ga, bb, cb, ub, gb = jnp.split(px, 8, axis=-1)
    qa = axial_rope(qa.reshape(B, S, A_HEADS, 2, A_QK), row, col)
    ka = axial_rope(ka.reshape(B, S, A_HEADS, 2, A_QK), row, col)
    va = va.reshape(B, S, A_HEADS, A_V)
    if need_ctx:
        qc, kc, vc, gc, bbc, cbc, ubc, gbc = jnp.split(pc, 8, axis=-1)
    else:
        kc, vc = jnp.split(pc, 2, axis=-1)
    kc = kc.reshape(B, L, A_HEADS, 2, A_QK)
    vc = vc.reshape(B, L, A_HEADS, A_V)
    lp = lam_p.astype(jnp.float32)
    lam = jnp.exp(jnp.sum(lp[0] * lp[1])) - jnp.exp(jnp.sum(lp[2] * lp[3])) + lam_init
    k_all = jnp.concatenate([kc, ka], axis=1)
    v_all = jnp.concatenate([vc, va], axis=1)
    nb = S // Q_BLOCK
    q_blocks = jnp.moveaxis(qa.reshape(B, nb, Q_BLOCK, A_HEADS, 2, A_QK), 1, 0)
    o = lax.map(lambda qb: diff_attend(qb, k_all, v_all, lam), q_blocks)
    o = jnp.moveaxis(o, 0, 1).reshape(B, S, A_HEADS, A_V)
    out_a = diff_attention_post(o, subln, lam_init).astype(px.dtype) * jax.nn.silu(ga)
    out_b = short_conv(bb, cb, ub, conv_w) * jax.nn.silu(gb)
    out_x = jnp.concatenate([out_a, out_b], axis=-1)
    if not need_ctx:
        return out_x, None
    oc = diff_attend(qc.reshape(B, L, A_HEADS, 2, A_QK), kc, vc, lam)
    out_ac = diff_attention_post(oc, subln, lam_init).astype(pc.dtype) * jax.nn.silu(gc)
    out_bc = short_conv(bbc, cbc, ubc, conv_w) * jax.nn.silu(gbc)
    return out_x, jnp.concatenate([out_ac, out_bc], axis=-1)


def odd_mixer(px, pc, rpb, need_ctx):
    B, S, _ = px.shape
    L = pc.shape[1]

    def heads(u):
        return u.reshape(u.shape[0], u.shape[1], C_HEADS, C_HEAD_DIM)

    qn, kn, vn, gn, ud, gd = jnp.split(px, 6, axis=-1)
    if need_ctx:
        qc, kc, vc, gc, udc, gdc = jnp.split(pc, 6, axis=-1)
    else:
        kc, vc = jnp.split(pc, 2, axis=-1)
    kc, vc = heads(kc), heads(vc)
    o_n = neighbourhood_attention(heads(qn), heads(kn), heads(vn), kc, vc, rpb)
    out_x = jnp.concatenate([o_n.astype(px.dtype) * jax.nn.silu(gn),
                             fourier_mix(ud) * jax.nn.silu(gd)], axis=-1)
    if not need_ctx:
        return out_x, None
    o_nc = dense_attend(heads(qc), kc, vc).reshape(B, L, BRANCH_W)
    out_c = jnp.concatenate([o_nc.astype(pc.dtype) * jax.nn.silu(gc),
                             fourier_mix(udc) * jax.nn.silu(gdc)], axis=-1)
    return out_x, out_c


def setup_inputs(seed: int = 0) -> dict:
    key = jax.random.key(seed)
    ks = jax.random.split(key, 15)
    f = jnp.float32
    nrm = jax.random.normal
    return {
        'x': nrm(ks[0], (BATCH, SEQ, D_MODEL), f),
        'c': nrm(ks[1], (BATCH, D_MODEL), f),
        'ctx': nrm(ks[2], (BATCH, CTX_LEN, D_MODEL), f),
        'c_ctx': nrm(ks[3], (D_MODEL,), f),
        'w_mod': nrm(ks[4], (DEPTH, D_MODEL, 3 * D_MODEL), f) * D_MODEL ** -0.5,
        'b_mod': 0.02 * nrm(ks[5], (DEPTH, 3 * D_MODEL), f),
        'norm_pre': 1.0 + 0.1 * nrm(ks[6], (DEPTH, D_MODEL), f),
        'norm_post': 1.0 + 0.1 * nrm(ks[7], (DEPTH, D_MODEL), f),
        'w_in_even': nrm(ks[8], (N_EVEN, D_MODEL, EVEN_IN), f) * D_MODEL ** -0.5,
        'lam_a': 0.1 * nrm(ks[9], (N_EVEN, 4, A_QK), f),
        'subln_a': 1.0 + 0.1 * nrm(ks[10], (N_EVEN, A_V), f),
        'conv_b': nrm(ks[11], (N_EVEN, CONV_W, BRANCH_W), f) * CONV_W ** -0.5,
        'w_in_odd': nrm(ks[12], (N_ODD, D_MODEL, ODD_IN), f) * D_MODEL ** -0.5,
        'rpb_c': 0.1 * nrm(ks[13], (N_ODD, C_HEADS, 2 * NA_KH - 1, 2 * NA_KW - 1), f),
        'w_out': nrm(ks[14], (DEPTH, D_MIX, D_MODEL), f) * D_MIX ** -0.5,
    }


def reference(x, c, ctx, c_ctx, w_mod, b_mod, norm_pre, norm_post, w_in_even, lam_a,
              subln_a, conv_b, w_in_odd, rpb_c, w_out):
    S = x.shape[1]
    t = jnp.arange(S)
    row = t // GRID_W
    col = t % GRID_W
    silu_c = jax.nn.silu(c)
    silu_cc = jax.nn.silu(c_ctx)
    for l in range(DEPTH):
        need_ctx = l < DEPTH - 1
        j = l // 2
        mod_x = (silu_c @ w_mod[l] + b_mod[l])[:, None, :]
        mod_c = (silu_cc @ w_mod[l] + b_mod[l])[None, None, :]
        sh_x, sc_x, g_x = jnp.split(mod_x, 3, axis=-1)
        sh_c, sc_c, g_c = jnp.split(mod_c, 3, axis=-1)
        hx = rms_norm(x, norm_pre[l]) * (1.0 + sc_x) + sh_x
        hc = rms_norm(ctx, norm_pre[l]) * (1.0 + sc_c) + sh_c
        w_in = w_in_even[j] if l % 2 == 0 else w_in_odd[j]
        px = hx @ w_in
        pc = hc @ (w_in if need_ctx else w_in[:, BRANCH_W:3 * BRANCH_W])
        if l % 2 == 0:
            mx, mc = even_mixer(px, pc, lam_a[j], subln_a[j], conv_b[j], lambda_init(l),
                                row, col, need_ctx)
        else:
            mx, mc = odd_mixer(px, pc, rpb_c[j], need_ctx)
        x = x + g_x * rms_norm(mx @ w_out[l], norm_post[l])
        if need_ctx:
            ctx = ctx + g_c * rms_norm(mc @ w_out[l], norm_post[l])
    return x
```

```cpp
#include <hip/hip_runtime.h>
#include <hip/hip_cooperative_groups.h>
#include <cstdio>
#include <cstdint>
namespace cg = cooperative_groups;

#ifndef PROBE_DUP
#define PROBE_DUP 0
#endif
#ifndef MULTI_LAUNCH
#define MULTI_LAUNCH 0
#endif

#define VTID  ((int)(threadIdx.x & 255))
#define VHALF ((int)(threadIdx.x >> 8))
#define VBLK  ((int)(blockIdx.x * 2 + (threadIdx.x >> 8)))
#define VGRID ((int)(gridDim.x * 2))
typedef unsigned short u16;
typedef unsigned __attribute__((ext_vector_type(4))) u32x4;
typedef unsigned __attribute__((ext_vector_type(2))) u32x2;
typedef float __attribute__((ext_vector_type(2))) f32x2;
typedef __attribute__((ext_vector_type(8))) short bf16x8;
typedef __attribute__((ext_vector_type(4))) float f32x4;
typedef __attribute__((ext_vector_type(2))) __bf16 bf2_t;
typedef __attribute__((ext_vector_type(2))) float f2_t;

#define TPB 4352
#define MTOT 34816
#define NPHASE 20
#define LOG2E 1.4426950408889634f
#define EPS 1e-6f

constexpr size_t OFF_WT_EVEN = 0;
constexpr size_t OFF_WT_ODD  = OFF_WT_EVEN + 2ull*4096*1024*2;
constexpr size_t OFF_WT_OUT  = OFF_WT_ODD + 2ull*3584*1024*2;
constexpr size_t OFF_MOD     = OFF_WT_OUT + 4ull*1024*1024*2;
constexpr size_t OFF_ROPE    = OFF_MOD + 4ull*9*3072*4;
constexpr size_t OFF_LAM     = OFF_ROPE + 4096;
constexpr size_t OFF_FM1     = OFF_LAM + 256;
constexpr size_t OFF_FM2     = OFF_FM1 + 128*128*2;
constexpr size_t OFF_TWC     = OFF_FM2 + 64*128*2;
constexpr size_t OFF_TWS     = OFF_TWC + 64*64*4;
constexpr size_t OFF_TG      = OFF_TWS + 64*64*4;
constexpr size_t OFF_DFTC    = OFF_TG + 8ull*64*512*128*2;
constexpr size_t OFF_H       = OFF_DFTC + 256ull*512*2;
constexpr size_t OFF_PX      = OFF_H + (size_t)MTOT*1024*2;
constexpr size_t OFF_ZT      = OFF_PX + (size_t)MTOT*2048*2;
constexpr size_t OFF_ZTC     = OFF_ZT + 8ull*512*8192*2;
constexpr size_t OFF_VT      = OFF_PX + (size_t)MTOT*3584*2;
constexpr size_t OFF_CS      = OFF_VT + 8ull*8*64*4352*2;
constexpr size_t OFF_SSQ     = OFF_CS + 2048ull*1024*4;
constexpr size_t OFF_BAR     = OFF_SSQ + (size_t)MTOT*16*4;
constexpr size_t BAR_BYTES   = 32768;
constexpr int SMEM_BYTES = 131072;
constexpr size_t OFF_BT      = OFF_BAR + BAR_BYTES;
constexpr size_t OFF_KMAX    = OFF_BT + 2ull*8*15*4096*4;
constexpr size_t WS_TOTAL    = OFF_KMAX + 1024;

struct Params {
  const float *x, *c, *ctx, *c_ctx, *w_mod, *b_mod, *norm_pre, *norm_post, *w_in_even, *lam_a,
              *subln_a, *conv_b, *w_in_odd, *rpb_c, *w_out;
  float* out;
  char* ws;
};

__device__ __forceinline__ float silu_f(float x) { return x / (1.f + __expf(-x)); }
__device__ __forceinline__ float bf2f(u16 v) { return __uint_as_float(((unsigned)v) << 16); }
__device__ __forceinline__ unsigned pack2(float a, float b) {
  f2_t v = {a, b};
  bf2_t r = __builtin_convertvector(v, bf2_t);
  return *(unsigned*)&r;
}
__device__ __forceinline__ u16 f2bf(float a) { return (u16)(pack2(a, 0.f) & 0xffff); }
__device__ __forceinline__ long blk(long row, int k, int KS) {
  return ((row >> 7) * KS + (k >> 6)) * 8192 + (row & 127) * 64 + (k & 63);
}
__device__ __forceinline__ int swz(int r, int c) { return r * 128 + ((c ^ ((r >> 1) & 7)) << 4); }
__device__ __forceinline__ f32x4 mfma16(bf16x8 a, bf16x8 b, f32x4 c) {
  return __builtin_amdgcn_mfma_f32_16x16x32_bf16(a, b, c, 0, 0, 0);
}
__device__ __forceinline__ float fexp2(float x) { return __builtin_amdgcn_exp2f(x); }

#define WAIT_V(n) asm volatile("s_waitcnt vmcnt(%0)" ::"n"(n) : "memory")
#define RAW_BARRIER() do { asm volatile("s_waitcnt lgkmcnt(0)" ::: "memory"); __builtin_amdgcn_s_barrier(); } while (0)
template <int NJ>
__device__ __forceinline__ void gemm_core(const u16* A, long rowA0, const u16* B, long rowB0, int K,
                                          f32x4 (&acc)[8][NJ], char* smem, int permA = -1) {
  const int t = threadIdx.x, lane = t & 63, wave = t >> 6;
  const int wr = wave >> 2, wc = wave & 3;
  const int lr = lane & 15, lg = lane >> 4;
  const int KS = K >> 6;
  constexpr int NBQ = NJ;
#pragma unroll
  for (int i = 0; i < 8; ++i)
#pragma unroll
    for (int j = 0; j < NJ; ++j) acc[i][j] = f32x4{0.f, 0.f, 0.f, 0.f};
  const u16* ap[4];
  const u16* bp[NBQ];
#pragma unroll
  for (int q = 0; q < 4; ++q) {
    int R = (q * 8 + wave) * 8 + (lane >> 3);
    int cl = (lane & 7) ^ ((R >> 1) & 7);
    long rowA = permA < 0 ? rowA0 + R : rowA0 + 64 * (R & 63) + 4 * permA + (R >> 6);
    ap[q] = A + blk(rowA, 0, KS) + cl * 8;
  }
#pragma unroll
  for (int q = 0; q < NBQ; ++q) {
    int R = (q * 8 + wave) * 8 + (lane >> 3);
    int cl = (lane & 7) ^ ((R >> 1) & 7);
    bp[q] = B + blk(rowB0 + R, 0, KS) + cl * 8;
  }
  const int fb0 = lr * 128 + ((lg ^ ((lr >> 1) & 7)) << 4);
  char* sw = smem + wave * 1024;
#define GEMM_ISSUE1(kt, pc) do { const int s_ = ((kt) & 1) * 65536; const long ko_ = (long)(kt) * 8192; \
    if ((pc) < 4) __builtin_amdgcn_global_load_lds((const unsigned*)(ap[(pc) & 3] + ko_), (unsigned*)(sw + s_ + ((pc) & 3) * 8192), 16, 0, 0); \
    else __builtin_amdgcn_global_load_lds((const unsigned*)(bp[((pc) - 4) % NBQ] + ko_), (unsigned*)(sw + s_ + 32768 + (((pc) - 4) % NBQ) * 8192), 16, 0, 0); } while (0)
  __syncthreads();
#pragma unroll
  for (int pc = 0; pc < 4 + NBQ; ++pc) GEMM_ISSUE1(0, pc);
#pragma unroll 1
  for (int kt = 0; kt < KS; ++kt) {
    WAIT_V(0);
    RAW_BARRIER();
    const bool more = kt + 1 < KS;
    const char* sa = smem + (kt & 1) * 65536;
    const char* sb = sa + 32768;
#pragma unroll
    for (int ks = 0; ks < 2; ++ks) {
      bf16x8 bfr[NJ];
#pragma unroll
      for (int j = 0; j < NJ; ++j) bfr[j] = *(const bf16x8*)(sb + wc * (NJ * 2048) + j * 2048 + (fb0 ^ (ks << 6)));
#pragma unroll
      for (int i = 0; i < 8; ++i) {
        bf16x8 af = *(const bf16x8*)(sa + wr * 16384 + i * 2048 + (fb0 ^ (ks << 6)));
        if (ks == 0 && i < 4 + NBQ) {
          __builtin_amdgcn_sched_barrier(0);
          if (more) GEMM_ISSUE1(kt + 1, i);
          __builtin_amdgcn_sched_barrier(0);
        }
#pragma unroll
        for (int j = 0; j < NJ; ++j) acc[i][j] = mfma16(af, bfr[j], acc[i][j]);
      }
    }
  }
#undef GEMM_ISSUE1

}

__device__ __forceinline__ void wtrans_tile(const float* W, int ldw, int k0, int n0src, u16* Wt, int n0dst, char* smem) {
  float(*tile)[65] = (float(*)[65])smem;
  const int t = VTID;
  __syncthreads();
#pragma unroll
  for (int i = 0; i < 16; ++i) {
    int kk = (t >> 6) + 4 * i, nn = t & 63;
    tile[kk][nn] = W[(long)(k0 + kk) * ldw + n0src + nn];
  }
  __syncthreads();
#pragma unroll
  for (int i = 0; i < 16; ++i) {
    int nn = (t >> 6) + 4 * i, kk = t & 63;
    Wt[blk(n0dst + nn, k0 + kk, 16)] = f2bf(tile[kk][nn]);
  }
}

__device__ __forceinline__ void phase_prep(const Params& p, char* smem) {
  const int t = VTID;
  u16* wt_even = (u16*)(p.ws + OFF_WT_EVEN);
  u16* wt_odd = (u16*)(p.ws + OFF_WT_ODD);
  u16* wt_out = (u16*)(p.ws + OFF_WT_OUT);
  float* modv = (float*)(p.ws + OFF_MOD);
  const int N_EVEN = 2048, N_ODDP = 1280, N_OUT = 1024, N_FOLD = 256, N_MOD = 384, N_BT = 240, N_DFT = 3, N_ROPE = 1;
  const int total = N_EVEN + N_ODDP + N_OUT + N_FOLD + N_MOD + N_BT + N_DFT + N_ROPE;
  for (int it = VBLK; it < total; it += VGRID) {
    int id = it;
    if (id < N_MOD) {
      int l = id / 96, jb = id % 96;
      float* sc = (float*)smem;
      float* red = (float*)(smem + 36864);
      __syncthreads();
      for (int idx = t; idx < 9 * 1024; idx += 256) {
        int r = idx >> 10, k = idx & 1023;
        float v = r < 8 ? p.c[r * 1024 + k] : p.c_ctx[k];
        sc[idx] = silu_f(v);
      }
      __syncthreads();
      int col = jb * 32 + (t & 31), kp = t >> 5;
      float a0 = 0, a1 = 0, a2 = 0, a3 = 0, a4 = 0, a5 = 0, a6 = 0, a7 = 0, a8 = 0;
      const float* wp = p.w_mod + ((long)l * 1024 + kp * 128) * 3072 + col;
      const float* sp = sc + kp * 128;
#pragma unroll 8
      for (int k = 0; k < 128; ++k) {
        float w = wp[(long)k * 3072];
        a0 += sp[k] * w; a1 += sp[1024 + k] * w; a2 += sp[2048 + k] * w; a3 += sp[3072 + k] * w;
        a4 += sp[4096 + k] * w; a5 += sp[5120 + k] * w; a6 += sp[6144 + k] * w; a7 += sp[7168 + k] * w;
        a8 += sp[8192 + k] * w;
      }
      float* rp = red + kp * 288 + (t & 31);
      rp[0] = a0; rp[32] = a1; rp[64] = a2; rp[96] = a3; rp[128] = a4; rp[160] = a5; rp[192] = a6; rp[224] = a7; rp[256] = a8;
      __syncthreads();
      for (int idx = t; idx < 288; idx += 256) {
        int r = idx >> 5, cc = idx & 31;
        float s = p.b_mod[l * 3072 + jb * 32 + cc];
#pragma unroll
        for (int q = 0; q < 8; ++q) s += red[q * 288 + r * 32 + cc];
        modv[(l * 9 + r) * 3072 + jb * 32 + cc] = s;
      }
      continue;
    }
    id -= N_MOD;
    if (id < N_EVEN) {
      int j = id >> 10, r = id & 1023, kt = r >> 6, nt = r & 63;
      wtrans_tile(p.w_in_even + (long)j * 1024 * 4096, 4096, kt * 64, nt * 64, wt_even + (long)j * 4096 * 1024, nt * 64, smem);
      continue;
    }
    id -= N_EVEN;
    if (id < N_ODDP) {
      int j = id / 640, r = id % 640, kt = r / 40, q = r % 40;
      int sec = q >> 3, nt = q & 7;
      int ssec = sec < 4 ? sec : 5;
      wtrans_tile(p.w_in_odd + (long)j * 1024 * 3072, 3072, kt * 64, ssec * 512 + nt * 64,
                  wt_odd + (long)j * 3584 * 1024, ssec * 512 + nt * 64, smem);
      continue;
    }
    id -= N_ODDP;
    if (id < N_OUT) {
      int l = id >> 8, r = id & 255, kt = r >> 4, nt = r & 15;
      wtrans_tile(p.w_out + (long)l * 1024 * 1024, 1024, kt * 64, nt * 64, wt_out + (long)l * 1024 * 1024, nt * 64, smem);
      continue;
    }
    id -= N_OUT;
    if (id < N_FOLD) {
      int j = id >> 7, r = id & 127, g = r >> 4, kb = r & 15;
      float(*u)[65] = (float(*)[65])smem;
      float* cosT = (float*)(smem + 64 * 65 * 4);
      float* sinT = cosT + 64;
      __syncthreads();
      const float* W = p.w_in_odd + (long)j * 1024 * 3072;
#pragma unroll
      for (int i = 0; i < 16; ++i) {
        int kk = (t >> 6) + 4 * i, cc = t & 63;
        u[kk][cc] = W[(long)(kb * 64 + kk) * 3072 + 2048 + g * 64 + cc];
      }
      if (t < 64) {
        float s, c;
        sincospif((float)t / 32.f, &s, &c);
        cosT[t] = c; sinT[t] = s;
      }
      __syncthreads();
      int kk = t & 63, cq = t >> 6;
      u16* dst = wt_odd + (long)j * 3584 * 1024;
      for (int c2 = cq * 16; c2 < cq * 16 + 16; ++c2) {
        float sr = 0.f, si = 0.f;
#pragma unroll 8
        for (int cc = 0; cc < 64; ++cc) {
          int idx = (cc * c2) & 63;
          float v = u[kk][cc];
          sr += v * cosT[idx];
          si -= v * sinT[idx];
        }
        dst[blk(4 * 512 + g * 64 + c2, kb * 64 + kk, 16)] = f2bf(sr);
        dst[blk(6 * 512 + g * 64 + c2, kb * 64 + kk, 16)] = f2bf(si);
      }
      continue;
    }
    id -= N_FOLD;
    if (id < N_BT) {
      int jh = id / 15, roff = id % 15;
      const float* src = p.rpb_c + (long)jh * 15 * 31 + roff * 31;
      float* dst = (float*)(p.ws + OFF_BT) + ((long)id * 256 + t) * 16;
      int w = t >> 6, lane = t & 63, lr = lane & 15, lg = lane >> 4;
      int qc = 16 * w + lr, cs = min(max(qc - 8, 0), 48);
#pragma unroll
      for (int k4 = 0; k4 < 4; ++k4) {
        f32x4 v;
#pragma unroll
        for (int e = 0; e < 4; ++e) {
          int kc = k4 * 16 + 4 * lg + e;
          bool valid = (kc >= cs) && (kc < cs + 16);
          v[e] = valid ? src[min(max(kc - qc + 15, 0), 30)] * LOG2E : -1e30f;
        }
        *(f32x4*)(dst + k4 * 4) = v;
      }
      continue;
    }
    id -= N_BT;
    if (id < N_DFT) {
      float* ct = (float*)smem;
      float* st = ct + 256;
      __syncthreads();
      if (id < 1) {
        u16* F1 = (u16*)(p.ws + OFF_FM1);
        u16* F2 = (u16*)(p.ws + OFF_FM2);
        float* TC = (float*)(p.ws + OFF_TWC);
        float* TS = (float*)(p.ws + OFF_TWS);
        if (t < 64) { float sn, cs; sincospif((float)t / 32.f, &sn, &cs); ct[t] = cs; st[t] = sn; }
        __syncthreads();
        for (int idx = t; idx < 128 * 128; idx += 256) {
          int row = idx >> 7, k = idx & 127;
          int rp = row >> 6, ap = row & 63, ri = k >> 6, a = k & 63;
          float cs = ct[(a * ap) & 63], sn = st[(a * ap) & 63];
          float v = (rp == 0) ? (ri == 0 ? cs : sn) : (ri == 0 ? -sn : cs);
          F1[idx] = f2bf(v);
        }
        for (int idx = t; idx < 64 * 128; idx += 256) {
          int bp = idx >> 7, k = idx & 127, ri = k >> 6, bb = k & 63;
          F2[idx] = f2bf(ri == 0 ? ct[(bb * bp) & 63] : st[(bb * bp) & 63]);
        }
        for (int idx = t; idx < 64 * 64; idx += 256) {
          int ap = idx >> 6, bb = idx & 63;
          float sn, cs;
          sincospif((float)(ap * bb) / 2048.f, &sn, &cs);
          TC[idx] = cs; TS[idx] = sn;
        }
      } else {
        u16* D = (u16*)(p.ws + OFF_DFTC);
        { float sn, cs; sincospif((float)t / 128.f, &sn, &cs); ct[t] = cs; st[t] = sn; }
        __syncthreads();
        for (int q = 0; q < 32; ++q) {
          int chunk = (id - 1) * 8192 + q * 256 + t;
          int row = chunk >> 6, col0 = (chunk & 63) * 8;
          int ri = col0 >> 8, n0 = col0 & 255;
          float v[8];
#pragma unroll
          for (int e = 0; e < 8; ++e) {
            int idx = (row * (n0 + e)) & 255;
            v[e] = ri ? st[idx] : ct[idx];
          }
          u32x4 o = {pack2(v[0], v[1]), pack2(v[2], v[3]), pack2(v[4], v[5]), pack2(v[6], v[7])};
          *(u32x4*)(D + blk(row, col0, 8)) = o;
        }
      }
      continue;
    }
    id -= N_DFT;
    {
      __syncthreads();
      __syncthreads();
      f32x2* tab = (f32x2*)(p.ws + OFF_ROPE);
      for (int i = t; i < 512; i += 256) {
        int pos = i >> 3, fi = i & 7;
        float inv = exp2f(-(float)fi * (13.287712379549449f / 8.f));
        float ang = (float)pos * inv;
        float s, c;
        sincospif(ang * 0.3183098861837907f, &s, &c);
        tab[i] = f32x2{c, s};
      }
      ((unsigned*)(p.ws + OFF_KMAX))[t] = 0u;
      if (t < 2) {
        const float* lp = p.lam_a + t * 128;
        float s1 = 0.f, s2 = 0.f;
#pragma unroll 1
        for (int i = 0; i < 32; ++i) { s1 += lp[i] * lp[32 + i]; s2 += lp[64 + i] * lp[96 + i]; }
        float lam_init = 0.8f - 0.6f * expf(-0.3f * (float)(2 * t));
        ((float*)(p.ws + OFF_LAM))[t] = expf(s1) - expf(s2) + lam_init;
      }
    }
  }
}

__device__ __forceinline__ void phase_rows(const Params& p, int l) {
  const int t = VTID, lane = t & 63, wave = t >> 6;
  const float* modv = (const float*)(p.ws + OFF_MOD);
  const u16* Y = (const u16*)(p.ws + OFF_PX);
  const float* SSQ = (const float*)(p.ws + OFF_SSQ);
  float* CS = (float*)(p.ws + OFF_CS);
  u16* H = (u16*)(p.ws + OFF_H);
  for (int it = VBLK; it < MTOT / 16; it += VGRID) {
    const int m0 = it * 16 + wave * 4;
    const int b = m0 / TPB, w0 = m0 - b * TPB;
    const bool isc = w0 < 256;
    if (l == 3 && isc) continue;
    const long srow0 = isc ? (long)(b * 256 + w0) : (long)(b * 4096 + w0 - 256);
    const float* xin0 = (l <= 0) ? ((isc ? p.ctx : p.x) + srow0 * 1024) : ((isc ? CS : p.out) + srow0 * 1024);
    float* xout0 = (isc ? CS : p.out) + srow0 * 1024;
    const int r = isc ? 8 : b;
    f32x4 xall[4][4];
    u32x2 yall[4][4];
    float ssall[4];
#pragma unroll
    for (int rr = 0; rr < 4; ++rr) {
#pragma unroll
      for (int i = 0; i < 4; ++i) xall[rr][i] = *(const f32x4*)(xin0 + rr * 1024 + lane * 4 + 256 * i);
      if (l >= 0) {
#pragma unroll
        for (int i = 0; i < 4; ++i) yall[rr][i] = *(const u32x2*)(Y + (long)(m0 + rr) * 1024 + lane * 4 + 256 * i);
        ssall[rr] = lane < 8 ? SSQ[(long)(m0 + rr) * 16 + lane] : 0.f;
      }
    }
#pragma unroll
    for (int rr = 0; rr < 4; ++rr) {
      const int m = m0 + rr;
      float* xout = xout0 + rr * 1024;
      f32x4 xv[4];
#pragma unroll
      for (int i = 0; i < 4; ++i) xv[i] = xall[rr][i];
      if (l >= 0) {
        float ss = ssall[rr];
#pragma unroll
        for (int o = 1; o < 64; o <<= 1) ss += __shfl_xor(ss, o);
        float rstd = rsqrtf(ss * (1.f / 1024.f) + EPS);
        const float* gp = modv + (l * 9 + r) * 3072 + 2048;
        const float* np = p.norm_post + l * 1024;
#pragma unroll
        for (int i = 0; i < 4; ++i) {
          int k = lane * 4 + 256 * i;
          u32x2 yb = yall[rr][i];
          f32x4 y = {bf2f(yb.x & 0xffff), bf2f(yb.x >> 16), bf2f(yb.y & 0xffff), bf2f(yb.y >> 16)};
          f32x4 g = *(const f32x4*)(gp + k);
          f32x4 n = *(const f32x4*)(np + k);
          xv[i].x += g.x * (y.x * rstd * n.x);
          xv[i].y += g.y * (y.y * rstd * n.y);
          xv[i].z += g.z * (y.z * rstd * n.z);
          xv[i].w += g.w * (y.w * rstd * n.w);
          *(f32x4*)(xout + k) = xv[i];
        }
      }
      if (l < 3) {
        int ln = l + 1;
        float ss = 0.f;
#pragma unroll
        for (int i = 0; i < 4; ++i) ss += xv[i].x * xv[i].x + xv[i].y * xv[i].y + xv[i].z * xv[i].z + xv[i].w * xv[i].w;
#pragma unroll
        for (int o = 1; o < 64; o <<= 1) ss += __shfl_xor(ss, o);
        float rstd = rsqrtf(ss * (1.f / 1024.f) + EPS);
        const float* mp = modv + (ln * 9 + r) * 3072;
        const float* np = p.norm_pre + ln * 1024;
#pragma unroll
        for (int i = 0; i < 4; ++i) {
          int k = lane * 4 + 256 * i;
          f32x4 sh = *(const f32x4*)(mp + k);
          f32x4 sc = *(const f32x4*)(mp + 1024 + k);
          f32x4 n = *(const f32x4*)(np + k);
          float h0 = xv[i].x * rstd * n.x * (1.f + sc.x) + sh.x;
          float h1 = xv[i].y * rstd * n.y * (1.f + sc.y) + sh.y;
          float h2 = xv[i].z * rstd * n.z * (1.f + sc.z) + sh.z;
          float h3 = xv[i].w * rstd * n.w * (1.f + sc.w) + sh.w;
          u32x2 o = {pack2(h0, h1), pack2(h2, h3)};
          *(u32x2*)(H + blk(m, k, 16)) = o;
        }
      }
    }
  }
}

template <bool NOSTORE = false>
__device__ __forceinline__ void phase_proj(const Params& p, int l, char* smem) {
  const int t = threadIdx.x, lane = t & 63, wave = t >> 6;
  const int wr = wave >> 2, wc = wave & 3, lr = lane & 15, lg = lane >> 4;
  const bool even = (l & 1) == 0;
  const int j = l >> 1;
  const u16* H = (const u16*)(p.ws + OFF_H);
  const u16* Wt = even ? (const u16*)(p.ws + OFF_WT_EVEN) + (long)j * 4096 * 1024
                       : (const u16*)(p.ws + OFF_WT_ODD) + (long)j * 3584 * 1024;
  u16* PX = (u16*)(p.ws + OFF_PX);
  u16* VT = (u16*)(p.ws + OFF_VT);
  u16* ZT = (u16*)(p.ws + OFF_ZT);
  u16* ZTC = (u16*)(p.ws + OFF_ZTC);
  const f32x2* rope = (const f32x2*)(p.ws + OFF_ROPE);
  const int pitch = even ? 3584 : 2048;
  const int NWN = even ? 14 : 8;
  const int NWT = even ? 2 : 6;
  const int n_normal = 136 * NWN, total = n_normal + 136 * NWT;
  for (int it = blockIdx.x; it < total; it += gridDim.x) {
    const bool trans = it >= n_normal;
    int b, sec, sc0, tw;
    if (!trans) {
      int tt = it % 136, wt = it / 136;
      b = tt / 17; tw = tt % 17;
      int sidx = wt >> 1;
      sec = even ? (sidx < 2 ? sidx : sidx + 1) : (sidx < 2 ? sidx : (sidx == 2 ? 3 : 5));
      sc0 = (wt & 1) * 256;
    } else {
      int it2 = it - n_normal;
      int tt = it2 / NWT, wt = it2 % NWT;
      b = tt / 17; tw = tt % 17;
      sec = even ? 2 : 2 + 2 * (wt >> 1);
      sc0 = (wt & 1) * 256;
    }
    const bool isc = tw == 0;
    if (l == 3 && isc && !(sec == 1 || sec == 2)) continue;
    f32x4 acc[8][4];
    const long rowW = (long)sec * 512 + sc0;
    const long rowH = (long)b * TPB + tw * 256;
    const bool zperm = trans && sec != 2 && !isc;
    gemm_core<4>(trans ? H : Wt, trans ? (zperm ? (long)(b * TPB + 256) : rowH) : rowW, trans ? Wt : H, trans ? rowW : rowH, 1024, acc, smem,
                 zperm ? tw - 1 : -1);
    if (NOSTORE) {
      float ss = 0.f;
#pragma unroll
      for (int i = 0; i < 8; ++i)
#pragma unroll
        for (int jj = 0; jj < 4; ++jj) ss += acc[i][jj][0] + acc[i][jj][1] + acc[i][jj][2] + acc[i][jj][3];
      if (ss == 12345.678f) PX[t] = 0;
      continue;
    }
    __syncthreads();
    char* wreg = smem + wave * 16384;
    const bool do_rope = !trans && even && sec < 2 && !isc;
#pragma unroll
    for (int jj = 0; jj < 4; ++jj)
#pragma unroll
      for (int i = 0; i < 8; ++i) {
        u32x2 o = {pack2(acc[i][jj][0], acc[i][jj][1]), pack2(acc[i][jj][2], acc[i][jj][3])};
        int c8 = i * 4 + lg;
        if (trans && sec == 2) c8 = (c8 & ~7) | ((c8 & 3) << 1) | ((c8 >> 2) & 1);
        *(u32x2*)(wreg + (jj * 16 + lr) * 256 + ((c8 ^ (lr << 1)) << 3)) = o;
      }
    __syncthreads();
    int pxcol;
    if (even) pxcol = sec < 2 ? sec * 512 : (sec - 1) * 512;
    else pxcol = sec == 0 ? 0 : sec == 1 ? 512 : sec == 3 ? 1024 : 1536;
    const bool knorm = !trans && even && sec == 1;
    float kmx = 0.f;
#pragma unroll 2
    for (int n = 0; n < 16; ++n) {
      int row = n * 4 + lg, k = lr;
      u32x4 v = *(const u32x4*)(wreg + row * 256 + ((k ^ (row & 15)) << 4));
      if (!trans) {
        long m = (long)b * TPB + tw * 256 + wc * 64 + row;
        if (do_rope) {
          u32x4 w = *(const u32x4*)(wreg + row * 256 + (((k ^ 1) ^ (row & 15)) << 4));
          int tl = tw * 256 - 256 + wc * 64 + row;
          int pos = ((k >> 1) & 1) ? (tl & 63) : (tl >> 6);
          const f32x4* rp = (const f32x4*)(rope + pos * 8);
          const float sg = (k & 1) ? 1.f : -1.f;
          u32x4 r;
#pragma unroll
          for (int e = 0; e < 4; ++e) {
            f32x4 cs = rp[e];
            float a0 = bf2f(v[e] & 0xffff), a1 = bf2f(v[e] >> 16), o0 = bf2f(w[e] & 0xffff), o1 = bf2f(w[e] >> 16);
            r[e] = pack2(a0 * cs[0] + sg * o0 * cs[1], a1 * cs[2] + sg * o1 * cs[3]);
          }
          v = r;
        }
        if (knorm) {
          float ssq = 0.f;
#pragma unroll
          for (int e = 0; e < 4; ++e) { float a0 = bf2f(v[e] & 0xffff), a1 = bf2f(v[e] >> 16); ssq += a0 * a0 + a1 * a1; }
          ssq += __shfl_xor(ssq, 1);
          ssq += __shfl_xor(ssq, 2);
          kmx = fmaxf(kmx, ssq);
        }
        *(u32x4*)(PX + m * pitch + pxcol + sc0 + wr * 128 + k * 8) = v;
      } else {
        int wcol = sc0 + wc * 64 + row;
        int tk = k * 8;
        if (sec == 2) {
          int h = wcol >> 6, d = wcol & 63;
          *(u32x4*)(VT + ((long)((b * 8 + h) * 64 + d)) * TPB + tw * 256 + wr * 128 + tk) = v;
        } else {
          int ri = sec == 6 ? 1 : 0;
          if (isc) *(u32x4*)(ZTC + blk(b * 512 + wcol, ri * 256 + wr * 128 + tk, 8)) = v;
          else     *(u32x4*)(ZT + ((long)((b * 512 + wcol) * 2 + ri)) * 4096 + (4 * (tw - 1) + wr * 2) * 64 + tk) = v;
        }
      }
    }
    if (knorm) {
      kmx = fmaxf(kmx, __shfl_xor(kmx, 16));
      kmx = fmaxf(kmx, __shfl_xor(kmx, 32));
      if (lg == 0 && (lr & 3) == 0) {
        int col = sc0 + wr * 128 + lr * 8;
        atomicMax((unsigned*)(p.ws + OFF_KMAX) + ((j * 8 + b) * 8 + (col >> 6)) * 2 + ((col >> 5) & 1), __float_as_uint(kmx));
      }
    }
  }
}

__device__ __forceinline__ void ld_tile64(const u16* base, long pitch, u32x4 (&r)[2]) {
  const int t = VTID, c = t & 7, r0 = t >> 3;
  r[0] = *(const u32x4*)(base + (long)r0 * pitch + c * 8);
  r[1] = *(const u32x4*)(base + (long)(r0 + 32) * pitch + c * 8);
}
__device__ __forceinline__ void st_tile64(char* s, const u32x4 (&r)[2]) {
  const int t = VTID, c = t & 7, r0 = t >> 3;
  *(u32x4*)(s + swz(r0, c)) = r[0];
  *(u32x4*)(s + swz(r0 + 32, c)) = r[1];
}
__device__ __forceinline__ bf16x8 ld_vfrag(const char* sV, int vb, int dt, int ks) {
  return *(const bf16x8*)(sV + dt * 2048 + (vb ^ (ks << 6)));
}

#define NQT 2
__device__ __forceinline__ void diff_attn_item(const Params& p, int l, int b, int h, int q0, int nkeys, char* smem) {
  const int t = VTID, lane = t & 63, wave = t >> 6, lr = lane & 15, lg = lane >> 4;
  const int j = l >> 1;
  const u16* PX = (const u16*)(p.ws + OFF_PX);
  const u16* VT = (const u16*)(p.ws + OFF_VT);
  u16* MX = (u16*)(p.ws + OFF_H);
  const int pitch = 3584;
  const float cexp = 0.17677669529663687f * LOG2E;
  const int kx = (lr >> 1) & 7;
  const int kb0 = lr * 128 + ((lg ^ kx) << 4);
  const int vb = kb0;
  int opq = 0;
  asm volatile("" : "+s"(opq));
  smem += opq;
  const float lam = ((const float*)(p.ws + OFF_LAM))[j + opq];
  const float one_m_li = 1.f - (0.8f - 0.6f * expf(-0.3f * (float)l));
  const long rowbase = (long)b * TPB;
  bf16x8 Q[2][NQT];
#pragma unroll
  for (int m = 0; m < 2; ++m)
#pragma unroll
    for (int qt = 0; qt < NQT; ++qt)
      Q[m][qt] = *(const bf16x8*)(PX + (rowbase + q0 + wave * (16 * NQT) + qt * 16 + lr) * pitch + h * 64 + m * 32 + lg * 8);
  f32x4 O[2][NQT][4], Ls[2][NQT];
  float Mx[2][NQT];
#pragma unroll
  for (int m = 0; m < 2; ++m) {
    const float kmax2 = __uint_as_float(((const unsigned*)(p.ws + OFF_KMAX))[((j * 8 + b) * 8 + h) * 2 + m + opq]);
#pragma unroll
    for (int qt = 0; qt < NQT; ++qt) {
      u32x4 qu = __builtin_bit_cast(u32x4, Q[m][qt]);
      float qs = 0.f;
#pragma unroll
      for (int e = 0; e < 4; ++e) { float a0 = bf2f(qu[e] & 0xffff), a1 = bf2f(qu[e] >> 16); qs += a0 * a0 + a1 * a1; }
      qs += __shfl_xor(qs, 16);
      qs += __shfl_xor(qs, 32);
      Mx[m][qt] = sqrtf(qs * kmax2) * (cexp * 1.001f) + 1e-3f - 32.f;
      Ls[m][qt] = f32x4{0.f, 0.f, 0.f, 0.f};
#pragma unroll
      for (int dt = 0; dt < 4; ++dt) O[m][qt][dt] = f32x4{0.f, 0.f, 0.f, 0.f};
    }
  }
  const u32x4 ones_u = {0x3F803F80u, 0x3F803F80u, 0x3F803F80u, 0x3F803F80u};
  const bf16x8 ones = __builtin_bit_cast(bf16x8, ones_u);
  const u16* kbase = PX + rowbase * pitch + 512 + h * 64;
  const u16* vbase = VT + (long)((b * 8 + h) * 64) * TPB;
  const u16* kp[2];
  const u16* vp[2];
#pragma unroll
  for (int q = 0; q < 2; ++q) {
    int R = (q * 4 + wave) * 8 + (lane >> 3);
    int cl = (lane & 7) ^ ((R >> 1) & 7);
    kp[q] = kbase + (long)R * pitch + cl * 8;
    vp[q] = vbase + (long)R * TPB + cl * 8;
  }
  char* sw = smem + wave * 1024;
#define ATT_ISSUE(kt) do { const int s_ = ((kt) & 3) * 16384; \
    __builtin_amdgcn_global_load_lds((const unsigned*)(kp[0] + (long)(kt) * 64 * pitch), (unsigned*)(sw + s_), 16, 0, 0); \
    __builtin_amdgcn_global_load_lds((const unsigned*)(kp[1] + (long)(kt) * 64 * pitch), (unsigned*)(sw + s_ + 4096), 16, 0, 0); \
    __builtin_amdgcn_global_load_lds((const unsigned*)(vp[0] + (kt) * 64), (unsigned*)(sw + s_ + 8192), 16, 0, 0); \
    __builtin_amdgcn_global_load_lds((const unsigned*)(vp[1] + (kt) * 64), (unsigned*)(sw + s_ + 12288), 16, 0, 0); } while (0)
  const int nkt = nkeys >> 6;
  __syncthreads();
  ATT_ISSUE(0);
  ATT_ISSUE(1);
  ATT_ISSUE(2);
#pragma unroll 4
  for (int kt = 0; kt < nkt; ++kt) {
    if (kt + 2 < nkt) WAIT_V(8);
    else if (kt + 1 < nkt) WAIT_V(4);
    else WAIT_V(0);
    RAW_BARRIER();
    if (kt + 3 < nkt) ATT_ISSUE(kt + 3);
    const char* sK = smem + (kt & 3) * 16384;
    const char* sV = sK + 8192;
#pragma unroll
    for (int m = 0; m < 2; ++m) {
      f32x4 S[NQT][4];
#pragma unroll
      for (int k4 = 0; k4 < 4; ++k4) {
        bf16x8 kf = *(const bf16x8*)(sK + k4 * 2048 + (kb0 ^ (m << 6)));
#pragma unroll
        for (int qt = 0; qt < NQT; ++qt) S[qt][k4] = mfma16(kf, Q[m][qt], f32x4{0.f, 0.f, 0.f, 0.f});
      }
      bf16x8 P[NQT][2];
#pragma unroll
      for (int qt = 0; qt < NQT; ++qt) {
        const float mref = Mx[m][qt];
#pragma unroll
        for (int k4 = 0; k4 < 4; ++k4) {
          f32x4 a4 = S[qt][k4] * cexp - mref;
#pragma unroll
          for (int e = 0; e < 4; ++e) S[qt][k4][e] = fexp2(a4[e]);
        }
#pragma unroll
        for (int ks = 0; ks < 2; ++ks) {
          u32x4 pu = {pack2(S[qt][2 * ks][0], S[qt][2 * ks][1]), pack2(S[qt][2 * ks][2], S[qt][2 * ks][3]),
                      pack2(S[qt][2 * ks + 1][0], S[qt][2 * ks + 1][1]), pack2(S[qt][2 * ks + 1][2], S[qt][2 * ks + 1][3])};
          P[qt][ks] = __builtin_bit_cast(bf16x8, pu);
        }
      }
#pragma unroll
      for (int ks = 0; ks < 2; ++ks)
#pragma unroll
        for (int qt = 0; qt < NQT; ++qt) Ls[m][qt] = mfma16(ones, P[qt][ks], Ls[m][qt]);
#pragma unroll
      for (int dt = 0; dt < 4; ++dt)
#pragma unroll
        for (int ks = 0; ks < 2; ++ks) {
          bf16x8 vf = ld_vfrag(sV, vb, dt, ks);
#pragma unroll
          for (int qt = 0; qt < NQT; ++qt) O[m][qt][dt] = mfma16(vf, P[qt][ks], O[m][qt][dt]);
        }
    }
  }
#undef ATT_ISSUE
  const float* sub = p.subln_a + j * 64 + opq;
#pragma unroll
  for (int qt = 0; qt < NQT; ++qt) {
    float l0 = Ls[0][qt][0], l1 = Ls[1][qt][0];
    float i0 = 1.f / l0, i1 = lam / l1;
    float ss = 0.f;
    f32x4 o[4];
#pragma unroll
    for (int dt = 0; dt < 4; ++dt) {
#pragma unroll
      for (int e = 0; e < 4; ++e) {
        float v = O[0][qt][dt][e] * i0 - O[1][qt][dt][e] * i1;
        o[dt][e] = v;
        ss += v * v;
      }
    }
    ss += __shfl_xor(ss, 16); ss += __shfl_xor(ss, 32);
    float rstd = rsqrtf(ss * (1.f / 64.f) + EPS) * one_m_li;
    long m = rowbase + q0 + wave * (16 * NQT) + qt * 16 + lr;
#pragma unroll
    for (int dt = 0; dt < 4; ++dt) {
      int d = dt * 16 + 4 * lg;
      u32x2 gg = *(const u32x2*)(PX + m * pitch + 1024 + h * 64 + d);
      f32x4 sw = *(const f32x4*)(sub + d);
      float g0 = bf2f(gg.x & 0xffff), g1 = bf2f(gg.x >> 16), g2 = bf2f(gg.y & 0xffff), g3 = bf2f(gg.y >> 16);
      float r0 = o[dt][0] * rstd * sw.x * silu_f(g0);
      float r1 = o[dt][1] * rstd * sw.y * silu_f(g1);
      float r2 = o[dt][2] * rstd * sw.z * silu_f(g2);
      float r3 = o[dt][3] * rstd * sw.w * silu_f(g3);
      u32x2 ov = {pack2(r0, r1), pack2(r2, r3)};
      *(u32x2*)(MX + blk(m, h * 64 + d, 16)) = ov;
    }
  }
}

__device__ __forceinline__ void conv_item(const Params& p, int l, int item) {
  const int t = VTID;
  const int j = l >> 1;
  const u16* PX = (const u16*)(p.ws + OFF_PX);
  u16* MX = (u16*)(p.ws + OFF_H);
  const int pitch = 3584;
  const int col = (t & 63) * 8, rsub = t >> 6;
  float w0[8], w1[8], w2[8];
  int opq = 0;
  asm volatile("" : "+s"(opq));
  const float* cw = p.conv_b + j * 3 * 512 + opq;
#pragma unroll
  for (int e = 0; e < 8; ++e) { w0[e] = cw[col + e]; w1[e] = cw[512 + col + e]; w2[e] = cw[1024 + col + e]; }
  for (int ps = 0; ps < 8; ++ps) {
    long m = (long)item * 32 + ps * 4 + rsub;
    int w = (int)(m % TPB);
    bool hp = (w != 0) && (w != 256), hn = (w != 255) && (w != TPB - 1);
    const u16* row = PX + m * pitch;
    u32x4 zero = {0, 0, 0, 0};
    u32x4 c1 = *(const u32x4*)(row + 2048 + col), u1 = *(const u32x4*)(row + 2560 + col);
    u32x4 c0 = hp ? *(const u32x4*)(row - pitch + 2048 + col) : zero, u0 = hp ? *(const u32x4*)(row - pitch + 2560 + col) : zero;
    u32x4 c2 = hn ? *(const u32x4*)(row + pitch + 2048 + col) : zero, u2 = hn ? *(const u32x4*)(row + pitch + 2560 + col) : zero;
    u32x4 bb = *(const u32x4*)(row + 1536 + col), gb = *(const u32x4*)(row + 3072 + col);
    const unsigned* pc0 = (const unsigned*)&c0; const unsigned* pu0 = (const unsigned*)&u0;
    const unsigned* pc1 = (const unsigned*)&c1; const unsigned* pu1 = (const unsigned*)&u1;
    const unsigned* pc2 = (const unsigned*)&c2; const unsigned* pu2 = (const unsigned*)&u2;
    const unsigned* pb = (const unsigned*)&bb; const unsigned* pg = (const unsigned*)&gb;
    float r[8];
#pragma unroll
    for (int e = 0; e < 8; ++e) {
      int sh = (e & 1) * 16, q = e >> 1;
      float z0 = bf2f((pc0[q] >> sh) & 0xffff) * bf2f((pu0[q] >> sh) & 0xffff);
      float z1 = bf2f((pc1[q] >> sh) & 0xffff) * bf2f((pu1[q] >> sh) & 0xffff);
      float z2 = bf2f((pc2[q] >> sh) & 0xffff) * bf2f((pu2[q] >> sh) & 0xffff);
      float y = z0 * w0[e] + z1 * w1[e] + z2 * w2[e];
      r[e] = bf2f((pb[q] >> sh) & 0xffff) * y * silu_f(bf2f((pg[q] >> sh) & 0xffff));
    }
    u32x4 o = {pack2(r[0], r[1]), pack2(r[2], r[3]), pack2(r[4], r[5]), pack2(r[6], r[7])};
    *(u32x4*)(MX + blk(m, 512 + col, 16)) = o;
  }
}

__device__ __forceinline__ void phase_mix_even(const Params& p, int l, char* smem) {
  const int QB = 64 * NQT;
  const int NQB = 4096 / QB, NCB = 256 / QB;
  const int N_ATT = 64 * NQB, N_CATT = 64 * NCB, N_CONV = MTOT / 32;
  for (int it = VBLK; it < N_ATT + N_CATT; it += VGRID) {
    int id = it;
    int b, h, q0, nkeys;
    if (id < N_ATT) { int bh = id / NQB; b = bh >> 3; h = bh & 7; q0 = 256 + (id % NQB) * QB; nkeys = TPB; }
    else { id -= N_ATT; int bh = id / NCB; b = bh >> 3; h = bh & 7; q0 = (id % NCB) * QB; nkeys = 256; }
    diff_attn_item(p, l, b, h, q0, nkeys, smem);
  }
  for (int it = (VBLK + VGRID - (N_CATT % VGRID)) % VGRID; it < N_CONV; it += VGRID) conv_item(p, l, it);
}

#define NQR 2
__device__ __forceinline__ void na_item(const Params& p, int l, int b, int h, int rg, bool win, char* smem) {
  const int t = VTID, lane = t & 63, wave = t >> 6, lr = lane & 15, lg = lane >> 4;
  const int j = l >> 1;
  const u16* PX = (const u16*)(p.ws + OFF_PX);
  const u16* VT = (const u16*)(p.ws + OFF_VT);
  u16* MX = (u16*)(p.ws + OFF_H);
  const int pitch = 2048;
  const float cexp = 0.125f * LOG2E;
  const int kx = (lr >> 1) & 7;
  const int kb0 = lr * 128 + ((lg ^ kx) << 4);
  const int vb = kb0;
  const long rowbase = (long)b * TPB;
  const int r0 = rg * NQR;
  const int ulo = win ? min(max(r0 - 4, 0), 56) : 0;
  const int nU = win ? (min(max(r0 + NQR - 5, 0), 56) + 7 - ulo + 1) : 0;
  const int ntile = nU + 4;
  int opq = 0;
  asm volatile("" : "+s"(opq));
  smem += opq;
  __syncthreads();
  const float* BT = (const float*)(p.ws + OFF_BT) + ((long)(j * 8 + h) * 15 * 256 + t) * 16;
  bf16x8 Q[NQR][2];
  const long mrow0 = rowbase + (win ? 256 : 0) + r0 * 64 + wave * 16 + lr;
#pragma unroll
  for (int qr = 0; qr < NQR; ++qr) {
#pragma unroll
    for (int ks = 0; ks < 2; ++ks) Q[qr][ks] = *(const bf16x8*)(PX + (mrow0 + 64 * qr) * pitch + h * 64 + ks * 32 + lg * 8);
  }
  f32x4 O[NQR][4], Ls[NQR];
  float Mx[NQR];
#pragma unroll
  for (int qr = 0; qr < NQR; ++qr) {
    Mx[qr] = -1e30f; Ls[qr] = f32x4{0.f, 0.f, 0.f, 0.f};
#pragma unroll
    for (int dt = 0; dt < 4; ++dt) O[qr][dt] = f32x4{0.f, 0.f, 0.f, 0.f};
  }
  const u32x4 ones_u = {0x3F803F80u, 0x3F803F80u, 0x3F803F80u, 0x3F803F80u};
  const bf16x8 ones = __builtin_bit_cast(bf16x8, ones_u);
  const u16* kbase = PX + rowbase * pitch + 512 + h * 64;
  const u16* vbase = VT + (long)((b * 8 + h) * 64) * TPB;
  auto keybase = [&](int tt) { return tt < nU ? 256 + (ulo + tt) * 64 : (tt - nU) * 64; };
  u32x4 rk[2], rv[2];
  {
    int kb = keybase(0);
    ld_tile64(kbase + (long)kb * pitch, pitch, rk);
    ld_tile64(vbase + kb, TPB, rv);
  }
  st_tile64(smem, rk);
  st_tile64(smem + 8192, rv);
  __syncthreads();
  const int qc = wave * 16 + lr;
  const int cs = min(max(qc - 8, 0), 48);
  const int k4lo = max(wave - 1, 0), k4hi = min(wave + 1, 3);
  for (int tt = 0; tt < NQR + 11; ++tt) {
    if (tt >= ntile) { __syncthreads(); continue; }
    const char* sK = smem + (tt & 1) * 16384;
    const char* sV = sK + 8192;
    if (tt + 1 < ntile) {
      int kb = keybase(tt + 1);
      ld_tile64(kbase + (long)kb * pitch, pitch, rk);
      ld_tile64(vbase + kb, TPB, rv);
    }
    const bool wt = tt < nU;
    const int u = ulo + tt;
#pragma unroll
    for (int qr = 0; qr < NQR; ++qr) {
      const int r = r0 + qr;
      const int rs = min(max(r - 4, 0), 56);
      if (wt && (u < rs || u > rs + 7)) continue;
      f32x4 S[4];
#pragma unroll
      for (int k4 = 0; k4 < 4; ++k4) {
        if (!wt || (k4 >= k4lo && k4 <= k4hi)) {
          S[k4] = mfma16(*(const bf16x8*)(sK + k4 * 2048 + kb0), Q[qr][0], f32x4{0.f, 0.f, 0.f, 0.f});
          S[k4] = mfma16(*(const bf16x8*)(sK + k4 * 2048 + (kb0 ^ 64)), Q[qr][1], S[k4]);
        } else {
          S[k4] = f32x4{-1e30f, -1e30f, -1e30f, -1e30f};
        }
      }
      if (wt) {
        const int roff = u - r + 7;
        const f32x4* bt = (const f32x4*)(BT + roff * 4096);
#pragma unroll
        for (int k4 = 0; k4 < 4; ++k4) {
          if (k4 >= k4lo && k4 <= k4hi) S[k4] = S[k4] * cexp + bt[k4];
        }
      } else {
#pragma unroll
        for (int k4 = 0; k4 < 4; ++k4) S[k4] *= cexp;
      }
      float mx = fmaxf(fmaxf(S[0][0], S[0][1]), fmaxf(S[0][2], S[0][3]));
#pragma unroll
      for (int k4 = 1; k4 < 4; ++k4) mx = fmaxf(fmaxf(mx, S[k4][0]), fmaxf(fmaxf(S[k4][1], S[k4][2]), S[k4][3]));
      if (__builtin_amdgcn_ballot_w64(mx > Mx[qr] + 8.f) != 0) {
        mx = fmaxf(mx, __shfl_xor(mx, 16));
        mx = fmaxf(mx, __shfl_xor(mx, 32));
        float mnew = fmaxf(Mx[qr], mx);
        float alpha = fexp2(Mx[qr] - mnew);
        Mx[qr] = mnew;
#pragma unroll
        for (int dt = 0; dt < 4; ++dt) O[qr][dt] *= alpha;
        Ls[qr] *= alpha;
      }
      const float mref = Mx[qr];
#pragma unroll
      for (int k4 = 0; k4 < 4; ++k4)
#pragma unroll
        for (int e = 0; e < 4; ++e) S[k4][e] = fexp2(S[k4][e] - mref);
#pragma unroll
      for (int ks = 0; ks < 2; ++ks) {
        u32x4 pu = {pack2(S[2 * ks][0], S[2 * ks][1]), pack2(S[2 * ks][2], S[2 * ks][3]),
                    pack2(S[2 * ks + 1][0], S[2 * ks + 1][1]), pack2(S[2 * ks + 1][2], S[2 * ks + 1][3])};
        bf16x8 pf = __builtin_bit_cast(bf16x8, pu);
        Ls[qr] = mfma16(ones, pf, Ls[qr]);
#pragma unroll
        for (int dt = 0; dt < 4; ++dt) O[qr][dt] = mfma16(ld_vfrag(sV, vb, dt, ks), pf, O[qr][dt]);
      }
    }
    if (tt + 1 < ntile) {
      char* ns = smem + ((tt + 1) & 1) * 16384;
      st_tile64(ns, rk);
      st_tile64(ns + 8192, rv);
    }
    __syncthreads();
  }
#pragma unroll
  for (int qr = 0; qr < NQR; ++qr) {
    float inv = 1.f / Ls[qr][0];
#pragma unroll
    for (int dt = 0; dt < 4; ++dt) {
      int d = dt * 16 + 4 * lg;
      u32x2 gg = *(const u32x2*)(PX + (mrow0 + 64 * qr) * pitch + 1024 + h * 64 + d);
      float g0 = bf2f(gg.x & 0xffff), g1 = bf2f(gg.x >> 16), g2 = bf2f(gg.y & 0xffff), g3 = bf2f(gg.y >> 16);
      u32x2 ov = {pack2(O[qr][dt][0] * inv * silu_f(g0), O[qr][dt][1] * inv * silu_f(g1)),
                  pack2(O[qr][dt][2] * inv * silu_f(g2), O[qr][dt][3] * inv * silu_f(g3))};
      *(u32x2*)(MX + blk(mrow0 + 64 * qr, h * 64 + d, 16)) = ov;
    }
  }
}

__device__ __forceinline__ void fourier_ctx_tile(const Params& p, int b, int nt, char* smem) {
  const int t = threadIdx.x, lane = t & 63, wave = t >> 6;
  const int wr = wave >> 2, wc = wave & 3, lr = lane & 15, lg = lane >> 4;
  const u16* PX = (const u16*)(p.ws + OFF_PX);
  u16* MX = (u16*)(p.ws + OFF_H);
  f32x4 acc[8][4];
  const u16* Ad = (const u16*)(p.ws + OFF_DFTC);
  const u16* Bz = (const u16*)(p.ws + OFF_ZTC);
  const float scale = 1.f / 128.f;
  const long mbase = (long)b * TPB;
  gemm_core<4>(Bz, (long)(b * 512 + nt * 256), Ad, 0, 512, acc, smem);
#pragma unroll
  for (int jj = 0; jj < 4; ++jj) {
    long m = mbase + wc * 64 + jj * 16 + lr;
#pragma unroll
    for (int i = 0; i < 8; ++i) {
      int col = nt * 256 + wr * 128 + i * 16 + 4 * lg;
      u32x2 gg = *(const u32x2*)(PX + m * 2048 + 1536 + col);
      float g0 = bf2f(gg.x & 0xffff), g1 = bf2f(gg.x >> 16), g2 = bf2f(gg.y & 0xffff), g3 = bf2f(gg.y >> 16);
      u32x2 ov = {pack2(acc[i][jj][0] * scale * silu_f(g0), acc[i][jj][1] * scale * silu_f(g1)),
                  pack2(acc[i][jj][2] * scale * silu_f(g2), acc[i][jj][3] * scale * silu_f(g3))};
      *(u32x2*)(MX + blk(m, 512 + col, 16)) = ov;
    }
  }
}

__device__ __forceinline__ void fft_stage1_item(const Params& p, int b, int colp) {
  const int t = VTID, lane = t & 63, wave = t >> 6, lr = lane & 15, lg = lane >> 4;
  const u16* F1 = (const u16*)(p.ws + OFF_FM1);
  const float* TC = (const float*)(p.ws + OFF_TWC);
  const float* TS = (const float*)(p.ws + OFF_TWS);
  u16* TG = (u16*)(p.ws + OFF_TG);
  const int ap = 16 * wave + lr;
  bf16x8 yf[2][4];
#pragma unroll
  for (int rp = 0; rp < 2; ++rp)
#pragma unroll
    for (int ks = 0; ks < 4; ++ks) yf[rp][ks] = *(const bf16x8*)(F1 + (rp * 64 + ap) * 128 + ks * 32 + lg * 8);
  bf16x8 xf[2][4][4];
#pragma unroll
  for (int c = 0; c < 2; ++c) {
    const u16* Z = (const u16*)(p.ws + OFF_ZT) + (long)(b * 512 + colp * 2 + c) * 8192;
#pragma unroll
    for (int i = 0; i < 4; ++i)
#pragma unroll
      for (int ks = 0; ks < 4; ++ks)
        xf[c][i][ks] = *(const bf16x8*)(Z + (ks >> 1) * 4096 + (16 * i + lr) * 64 + (ks & 1) * 32 + lg * 8);
  }
#pragma unroll
  for (int c = 0; c < 2; ++c) {
    const int col = colp * 2 + c;
    u16* dst = TG + ((long)(b * 64 + ap) * 512 + col) * 128;
#pragma unroll
    for (int i = 0; i < 4; ++i) {
      f32x4 tr = f32x4{0.f, 0.f, 0.f, 0.f}, ti = f32x4{0.f, 0.f, 0.f, 0.f};
#pragma unroll
      for (int ks = 0; ks < 4; ++ks) {
        tr = mfma16(xf[c][i][ks], yf[0][ks], tr);
        ti = mfma16(xf[c][i][ks], yf[1][ks], ti);
      }
      int bb0 = 16 * i + 4 * lg;
      f32x4 tc = *(const f32x4*)(TC + ap * 64 + bb0);
      f32x4 ts = *(const f32x4*)(TS + ap * 64 + bb0);
      f32x4 nr = tr * tc + ti * ts;
      f32x4 ni = ti * tc - tr * ts;
      u32x2 o0 = {pack2(nr[0], nr[1]), pack2(nr[2], nr[3])};
      u32x2 o1 = {pack2(ni[0], ni[1]), pack2(ni[2], ni[3])};
      *(u32x2*)(dst + bb0) = o0;
      *(u32x2*)(dst + 64 + bb0) = o1;
    }
  }
}

__device__ __forceinline__ void fft_stage2_item(const Params& p, int b, int ap, int ct) {
  const int t = VTID, lane = t & 63, wave = t >> 6, lr = lane & 15, lg = lane >> 4;
  const u16* T = (const u16*)(p.ws + OFF_TG) + ((long)(b * 64 + ap) * 512 + ct * 128) * 128;
  const u16* F2 = (const u16*)(p.ws + OFF_FM2);
  const u16* PX = (const u16*)(p.ws + OFF_PX);
  u16* MX = (u16*)(p.ws + OFF_H);
  bf16x8 yf[4][4];
#pragma unroll
  for (int jj = 0; jj < 4; ++jj)
#pragma unroll
    for (int ks = 0; ks < 4; ++ks) yf[jj][ks] = *(const bf16x8*)(F2 + (16 * jj + lr) * 128 + ks * 32 + lg * 8);
#pragma unroll
  for (int mi = 0; mi < 2; ++mi) {
    bf16x8 xf[4];
#pragma unroll
    for (int ks = 0; ks < 4; ++ks) xf[ks] = *(const bf16x8*)(T + (wave * 32 + mi * 16 + lr) * 128 + ks * 32 + lg * 8);
#pragma unroll
    for (int jj = 0; jj < 4; ++jj) {
      f32x4 acc = f32x4{0.f, 0.f, 0.f, 0.f};
#pragma unroll
      for (int ks = 0; ks < 4; ++ks) acc = mfma16(xf[ks], yf[jj][ks], acc);
      int bp = 16 * jj + lr;
      long m = (long)b * TPB + 256 + ap + 64 * bp;
      int col = ct * 128 + wave * 32 + mi * 16 + 4 * lg;
      u32x2 gg = *(const u32x2*)(PX + m * 2048 + 1536 + col);
      float g0 = bf2f(gg.x & 0xffff), g1 = bf2f(gg.x >> 16), g2 = bf2f(gg.y & 0xffff), g3 = bf2f(gg.y >> 16);
      const float scale = 1.f / 512.f;
      u32x2 ov = {pack2(acc[0] * scale * silu_f(g0), acc[1] * scale * silu_f(g1)),
                  pack2(acc[2] * scale * silu_f(g2), acc[3] * scale * silu_f(g3))};
      *(u32x2*)(MX + blk(m, 512 + col, 16)) = ov;
    }
  }
}

__device__ __forceinline__ void phase_mix_odd(const Params& p, int l, char* smem) {
  const bool need_ctx = l < 3;
  const int N_F1 = 4096, N_NA = 64 * (64 / NQR), N_CA = need_ctx ? 64 * (4 / NQR) : 0, N_FC = need_ctx ? 16 : 0;
  for (int rep = 0; rep < ((PROBE_DUP & 512) ? 2 : 1); ++rep)
  for (int it = VBLK; it < N_NA + N_CA; it += VGRID) {
    int id = it;
    bool win = id < N_NA;
    int b, h, r;
    if (win) { int bh = id / (64 / NQR); b = bh >> 3; h = bh & 7; r = id % (64 / NQR); }
    else { id -= N_NA; int bh = id / (4 / NQR); b = bh >> 3; h = bh & 7; r = id % (4 / NQR); }
    na_item(p, l, b, h, r, win, smem + VHALF * 65536);
  }
  for (int rep = 0; rep < ((PROBE_DUP & 256) ? 2 : 1); ++rep)
  for (int it = VBLK; it < N_F1 / 2; it += VGRID) fft_stage1_item(p, it >> 8, it & 255);
  for (int it = blockIdx.x; it < N_FC; it += gridDim.x) {
    fourier_ctx_tile(p, it >> 1, it & 1, smem);
  }
}
__device__ __forceinline__ void phase_mix_odd_b(const Params& p) {
  for (int rep = 0; rep < ((PROBE_DUP & 1024) ? 2 : 1); ++rep)
  for (int it = VBLK; it < 2048; it += VGRID) fft_stage2_item(p, it >> 8, (it >> 2) & 63, it & 3);
}

template <int NJ>
__device__ __forceinline__ void out_tile(const Params& p, int l, long row0, int nt, char* smem) {
  const int t = threadIdx.x, lane = t & 63, wave = t >> 6;
  const int wr = wave >> 2, wc = wave & 3, lr = lane & 15, lg = lane >> 4;
  const u16* MX = (const u16*)(p.ws + OFF_H);
  const u16* Wt = (const u16*)(p.ws + OFF_WT_OUT) + (long)l * 1024 * 1024;
  u16* Y = (u16*)(p.ws + OFF_PX);
  float* SSQ = (float*)(p.ws + OFF_SSQ);
  f32x4 acc[8][NJ];
  gemm_core<NJ>(Wt, (long)nt * 256, MX, row0, 1024, acc, smem);
#pragma unroll
  for (int jj = 0; jj < NJ; ++jj) {
    long m = row0 + wc * (16 * NJ) + jj * 16 + lr;
    float ss = 0.f;
#pragma unroll
    for (int i = 0; i < 8; ++i) {
      f32x4 v = acc[i][jj];
      ss += v[0] * v[0] + v[1] * v[1] + v[2] * v[2] + v[3] * v[3];
      u32x2 o = {pack2(v[0], v[1]), pack2(v[2], v[3])};
      *(u32x2*)(Y + m * 1024 + nt * 256 + wr * 128 + i * 16 + 4 * lg) = o;
    }
    ss += __shfl_xor(ss, 16);
    ss += __shfl_xor(ss, 32);
    if (lg == 0) SSQ[m * 16 + nt * 2 + wr] = ss;
  }
}
__device__ __forceinline__ void phase_out(const Params& p, int l, char* smem) {
  for (int it = blockIdx.x; it < 1024; it += gridDim.x) {
    int lt = it >> 2, nt = it & 3;
    int b = lt >> 5, j = lt & 31;
    out_tile<2>(p, l, (long)(b * 34 + 2 + j) * 128, nt, smem);
  }
  if (l < 3) {
    for (int id = blockIdx.x; id < 128; id += gridDim.x) {
      int nt = id & 3, h64 = (id >> 2) & 1, cm = id >> 3;
      int b = cm >> 1;
      out_tile<1>(p, l, (long)(b * 34 + (cm & 1)) * 128 + h64 * 64, nt, smem);
    }
  }
}

#define XB_TMO      128
#define XB_XCNT(j)  (256  + 64 * (j))
#define XB_XSUB(j)  (1280 + 64 * (j))
#define XB_XGEN(j)  (2304 + 64 * (j))
#define XB_TOP      3328
#define XB_TOPGEN   3392
#define XB_PERWG    3456
#define XB_SPIN_CAP (1u << 20)
__device__ __forceinline__ unsigned xb_ld(unsigned* p)              { return __hip_atomic_load(p, __ATOMIC_RELAXED, __HIP_MEMORY_SCOPE_AGENT); }
__device__ __forceinline__ unsigned xb_add(unsigned* p, unsigned v) { return __hip_atomic_fetch_add(p, v, __ATOMIC_RELAXED, __HIP_MEMORY_SCOPE_AGENT); }
__device__ __forceinline__ unsigned xb_xcc_id() { return (unsigned)__builtin_amdgcn_s_getreg((3 << 11) | 20) & 0xFu; }
#define XB_SPIN(cond, bar) do { unsigned _sp = 0; while (cond) { __builtin_amdgcn_s_sleep(1); \
    if ((++_sp & 255u) == 0u) { if (xb_ld(&(bar)[XB_TMO])) break; if (_sp > XB_SPIN_CAP) { atomicAdd(&(bar)[XB_TMO], 1u); break; } } } } while (0)
__device__ __forceinline__ void xcd_barrier_post(unsigned* bar) {
  if (threadIdx.x == 0) (void)xb_add(&bar[XB_XCNT(xb_xcc_id())], 1u);
}
__device__ __forceinline__ void xcd_barrier_complete(unsigned* bar, unsigned x, unsigned& nloc, unsigned& nx) {
  const unsigned G = gridDim.x;
  unsigned sum, cnt, mine, sp = 0u;
  for (;;) {
    sum = 0u; cnt = 0u; mine = 0u;
#pragma unroll
    for (unsigned j = 0; j < 16; ++j) { const unsigned c = xb_ld(&bar[XB_XCNT(j)]); sum += c; cnt += (c > 0u) ? 1u : 0u; mine = (j == x) ? c : mine; }
    if (sum == G) break;
    __builtin_amdgcn_s_sleep(1);
    if ((++sp & 255u) == 0u) { if (xb_ld(&bar[XB_TMO])) break; if (sp > XB_SPIN_CAP) { atomicAdd(&bar[XB_TMO], 1u); break; } }
  }
  nloc = mine > 0u ? mine : 1u; nx = cnt > 0u ? cnt : 1u;
}
__device__ __forceinline__ void xcd_barrier(unsigned* bar) {
  asm volatile("s_waitcnt vmcnt(0)" ::: "memory");
  __syncthreads();
  if (threadIdx.x == 0) {
    __builtin_amdgcn_s_waitcnt(0);
    const unsigned x = xb_xcc_id();
    unsigned* mine = bar + XB_PERWG + 2 * blockIdx.x;
    unsigned nloc = mine[0], nx = mine[1];
    if (nloc == 0u) { xcd_barrier_complete(bar, x, nloc, nx); mine[0] = nloc; mine[1] = nx; }
    const unsigned old = xb_add(&bar[XB_XSUB(x)], 1u);
    const unsigned gen = old / nloc;
    if (old + 1u == (gen + 1u) * nloc) {
      __builtin_amdgcn_fence(__ATOMIC_RELEASE, "agent");
      asm volatile("s_waitcnt vmcnt(0)" ::: "memory");
      const unsigned og = xb_add(&bar[XB_TOP], 1u);
      const unsigned tg = og / nx;
      if (og + 1u == (tg + 1u) * nx) xb_add(&bar[XB_TOPGEN], 1u);
      else XB_SPIN(xb_ld(&bar[XB_TOPGEN]) == tg, bar);
      __builtin_amdgcn_fence(__ATOMIC_ACQUIRE, "agent");
      xb_add(&bar[XB_XGEN(x)], 1u);
      asm volatile("s_waitcnt vmcnt(0)" ::: "memory");
    } else {
      XB_SPIN(xb_ld(&bar[XB_XGEN(x)]) == gen, bar);
      __builtin_amdgcn_fence(__ATOMIC_ACQUIRE, "agent");
      asm volatile("s_waitcnt vmcnt(0)" ::: "memory");
    }
  }
  __syncthreads();
}

#define GSYNC(PH) do { xcd_barrier(bar); } while (0)
#define RUN_PHASE(PH, CALL) if (PH >= ph_lo && PH < ph_hi) { if (PH > ph_lo) GSYNC(PH); CALL; }
#define RUN_PHASE_N(PH, L) if (PROBE_DUP & 2048) { GSYNC(PH); phase_proj<true>(p, L, smem); }
#define RUN_PHASE_D(BIT, PH, CALL) if (PH >= ph_lo && PH < ph_hi) { if (PH > ph_lo) GSYNC(PH); CALL; if (PROBE_DUP & (BIT)) { GSYNC(PH); CALL; } }
__global__ void __launch_bounds__(512, 2) mega(Params p, int ph_lo, int ph_hi) {
  extern __shared__ __attribute__((aligned(16))) char smem[];
  cg::grid_group grid = cg::this_grid();
  char* smh = smem + VHALF * 65536;
  unsigned* bar = (unsigned*)(p.ws + OFF_BAR);
  if (ph_lo < 0) grid.sync();
  xcd_barrier_post(bar);
  RUN_PHASE_D(16, 0, phase_prep(p, smh));
  RUN_PHASE_D(32, 1, phase_rows(p, -1));
  RUN_PHASE_D(1, 2, phase_proj(p, 0, smem));
  RUN_PHASE_N(2, 0);
  RUN_PHASE_D(2, 3, phase_mix_even(p, 0, smh));
  RUN_PHASE_D(8, 4, phase_out(p, 0, smem));
  RUN_PHASE(5, phase_rows(p, 0));
  RUN_PHASE_D(1, 6, phase_proj(p, 1, smem));
  RUN_PHASE_N(6, 1);
  RUN_PHASE_D(4, 7, phase_mix_odd(p, 1, smem));
  RUN_PHASE_D(4, 8, phase_mix_odd_b(p));
  RUN_PHASE_D(8, 9, phase_out(p, 1, smem));
  RUN_PHASE(10, phase_rows(p, 1));
  RUN_PHASE_D(1, 11, phase_proj(p, 2, smem));
  RUN_PHASE_N(11, 2);
  RUN_PHASE_D(2, 12, phase_mix_even(p, 2, smh));
  RUN_PHASE_D(8, 13, phase_out(p, 2, smem));
  RUN_PHASE(14, phase_rows(p, 2));
  RUN_PHASE_D(1, 15, phase_proj(p, 3, smem));
  RUN_PHASE_N(15, 3);
  RUN_PHASE_D(4, 16, phase_mix_odd(p, 3, smem));
  RUN_PHASE_D(4, 17, phase_mix_odd_b(p));
  RUN_PHASE_D(8, 18, phase_out(p, 3, smem));
  RUN_PHASE(19, phase_rows(p, 3));
}

extern "C" void kernel_launch(void* const* d_in, const int* in_sizes, int n_in, void* d_out, int out_size,
                              void* d_ws, size_t ws_size, hipStream_t stream) {
  static int grid_blocks = 0;
  if (!grid_blocks) {
    int dev = 0, cus = 0, per_cu = 0;
    hipGetDevice(&dev);
    hipDeviceGetAttribute(&cus, hipDeviceAttributeMultiprocessorCount, dev);
    hipFuncSetAttribute((const void*)mega, hipFuncAttributeMaxDynamicSharedMemorySize, SMEM_BYTES);
    hipOccupancyMaxActiveBlocksPerMultiprocessor(&per_cu, mega, 512, SMEM_BYTES);
    if (per_cu < 1) per_cu = 1;
    if (per_cu > 1) per_cu = 1;
    grid_blocks = cus * per_cu;
  }
  Params p{};
  p.x = (const float*)d_in[0]; p.c = (const float*)d_in[1]; p.ctx = (const float*)d_in[2]; p.c_ctx = (const float*)d_in[3];
  p.w_mod = (const float*)d_in[4]; p.b_mod = (const float*)d_in[5]; p.norm_pre = (const float*)d_in[6];
  p.norm_post = (const float*)d_in[7]; p.w_in_even = (const float*)d_in[8]; p.lam_a = (const float*)d_in[9];
  p.subln_a = (const float*)d_in[10]; p.conv_b = (const float*)d_in[11]; p.w_in_odd = (const float*)d_in[12];
  p.rpb_c = (const float*)d_in[13]; p.w_out = (const float*)d_in[14];
  p.out = (float*)d_out;
  p.ws = (char*)d_ws;
  if (ws_size < WS_TOTAL) fprintf(stderr, "workspace too small: %zu < %zu\n", ws_size, (size_t)WS_TOTAL);
#if MULTI_LAUNCH
  for (int ph = 0; ph < NPHASE; ++ph) {
    hipLaunchKernelGGL(mega, dim3(grid_blocks), dim3(512), SMEM_BYTES, stream, p, ph, ph + 1);
  }
#else
  int lo = 0, hi = NPHASE;
  void* args[] = {&p, &lo, &hi};
  hipMemsetAsync((char*)d_ws + OFF_BAR, 0, BAR_BYTES, stream);
  hipError_t e = hipLaunchCooperativeKernel((void*)mega, dim3(grid_blocks), dim3(512), args, SMEM_BYTES, stream);
  if (e != hipSuccess) fprintf(stderr, "cooperative launch failed: %s (grid %d)\n", hipGetErrorString(e), grid_blocks);
#endif
}
```

```cpp
#include <hip/hip_runtime.h>
#include <hip/hip_cooperative_groups.h>
#include <cstdio>
#include <cstdint>
namespace cg = cooperative_groups;

#ifndef PROBE_DUP
#define PROBE_DUP 0
#endif
#ifndef MULTI_LAUNCH
#define MULTI_LAUNCH 0
#endif

#define VTID  ((int)(threadIdx.x & 255))
#define VHALF ((int)(threadIdx.x >> 8))
#define VBLK  ((int)(blockIdx.x * 2 + (threadIdx.x >> 8)))
#define VGRID ((int)(gridDim.x * 2))
typedef unsigned short u16;
typedef unsigned __attribute__((ext_vector_type(4))) u32x4;
typedef unsigned __attribute__((ext_vector_type(2))) u32x2;
typedef float __attribute__((ext_vector_type(2))) f32x2;
typedef __attribute__((ext_vector_type(8))) short bf16x8;
typedef __attribute__((ext_vector_type(4))) float f32x4;
typedef __attribute__((ext_vector_type(2))) __bf16 bf2_t;
typedef __attribute__((ext_vector_type(2))) float f2_t;

#define TPB 4352
#define MTOT 34816
#define NPHASE 20
#define LOG2E 1.4426950408889634f
#define EPS 1e-6f

constexpr size_t OFF_WT_EVEN = 0;
constexpr size_t OFF_WT_ODD  = OFF_WT_EVEN + 2ull*4096*1024*2;
constexpr size_t OFF_WT_OUT  = OFF_WT_ODD + 2ull*3584*1024*2;
constexpr size_t OFF_MOD     = OFF_WT_OUT + 4ull*1024*1024*2;
constexpr size_t OFF_ROPE    = OFF_MOD + 4ull*9*3072*4;
constexpr size_t OFF_LAM     = OFF_ROPE + 4096;
constexpr size_t OFF_FM1     = OFF_LAM + 256;
constexpr size_t OFF_FM2     = OFF_FM1 + 128*128*2;
constexpr size_t OFF_TWC     = OFF_FM2 + 64*128*2;
constexpr size_t OFF_TWS     = OFF_TWC + 64*64*4;
constexpr size_t OFF_TG      = OFF_TWS + 64*64*4;
constexpr size_t OFF_DFTC    = OFF_TG + 8ull*64*512*128*2;
constexpr size_t OFF_H       = OFF_DFTC + 256ull*512*2;
constexpr size_t OFF_PX      = OFF_H + (size_t)MTOT*1024*2;
constexpr size_t OFF_ZT      = OFF_PX + (size_t)MTOT*2048*2;
constexpr size_t OFF_ZTC     = OFF_ZT + 8ull*512*8192*2;
constexpr size_t OFF_VT      = OFF_PX + (size_t)MTOT*3584*2;
constexpr size_t OFF_CS      = OFF_VT + 8ull*8*64*4352*2;
constexpr size_t OFF_SSQ     = OFF_CS + 2048ull*1024*4;
constexpr size_t OFF_BAR     = OFF_SSQ + (size_t)MTOT*16*4;
constexpr size_t BAR_BYTES   = 32768;
constexpr int SMEM_BYTES = 131072;
constexpr size_t OFF_BT      = OFF_BAR + BAR_BYTES;
constexpr size_t OFF_KMAX    = OFF_BT + 2ull*8*15*4096*4;
constexpr size_t WS_TOTAL    = OFF_KMAX + 1024;

struct Params {
  const float *x, *c, *ctx, *c_ctx, *w_mod, *b_mod, *norm_pre, *norm_post, *w_in_even, *lam_a,
              *subln_a, *conv_b, *w_in_odd, *rpb_c, *w_out;
  float* out;
  char* ws;
};

__device__ __forceinline__ float silu_f(float x) { return x / (1.f + __expf(-x)); }
__device__ __forceinline__ float bf2f(u16 v) { return __uint_as_float(((unsigned)v) << 16); }
__device__ __forceinline__ unsigned pack2(float a, float b) {
  f2_t v = {a, b};
  bf2_t r = __builtin_convertvector(v, bf2_t);
  return *(unsigned*)&r;
}
__device__ __forceinline__ u16 f2bf(float a) { return (u16)(pack2(a, 0.f) & 0xffff); }
__device__ __forceinline__ long blk(long row, int k, int KS) {
  return ((row >> 7) * KS + (k >> 6)) * 8192 + (row & 127) * 64 + (k & 63);
}
__device__ __forceinline__ int swz(int r, int c) { return r * 128 + ((c ^ ((r >> 1) & 7)) << 4); }
__device__ __forceinline__ f32x4 mfma16(bf16x8 a, bf16x8 b, f32x4 c) {
  return __builtin_amdgcn_mfma_f32_16x16x32_bf16(a, b, c, 0, 0, 0);
}
__device__ __forceinline__ float fexp2(float x) { return __builtin_amdgcn_exp2f(x); }

#define WAIT_V(n) asm volatile("s_waitcnt vmcnt(%0)" ::"n"(n) : "memory")
#define RAW_BARRIER() do { asm volatile("s_waitcnt lgkmcnt(0)" ::: "memory"); __builtin_amdgcn_s_barrier(); } while (0)
template <int NJ>
__device__ __forceinline__ void gemm_core(const u16* A, long rowA0, const u16* B, long rowB0, int K,
                                          f32x4 (&acc)[8][NJ], char* smem, int permA = -1) {
  const int t = threadIdx.x, lane = t & 63, wave = t >> 6;
  const int wr = wave >> 2, wc = wave & 3;
  const int lr = lane & 15, lg = lane >> 4;
  const int KS = K >> 6;
  constexpr int NBQ = NJ;
#pragma unroll
  for (int i = 0; i < 8; ++i)
#pragma unroll
    for (int j = 0; j < NJ; ++j) acc[i][j] = f32x4{0.f, 0.f, 0.f, 0.f};
  const u16* ap[4];
  const u16* bp[NBQ];
#pragma unroll
  for (int q = 0; q < 4; ++q) {
    int R = (q * 8 + wave) * 8 + (lane >> 3);
    int cl = (lane & 7) ^ ((R >> 1) & 7);
    long rowA = permA < 0 ? rowA0 + R : rowA0 + 64 * (R & 63) + 4 * permA + (R >> 6);
    ap[q] = A + blk(rowA, 0, KS) + cl * 8;
  }
#pragma unroll
  for (int q = 0; q < NBQ; ++q) {
    int R = (q * 8 + wave) * 8 + (lane >> 3);
    int cl = (lane & 7) ^ ((R >> 1) & 7);
    bp[q] = B + blk(rowB0 + R, 0, KS) + cl * 8;
  }
  const int fb0 = lr * 128 + ((lg ^ ((lr >> 1) & 7)) << 4);
  char* sw = smem + wave * 1024;
#define GEMM_ISSUE1(kt, pc) do { const int s_ = ((kt) & 1) * 65536; const long ko_ = (long)(kt) * 8192; \
    if ((pc) < 4) __builtin_amdgcn_global_load_lds((const unsigned*)(ap[(pc) & 3] + ko_), (unsigned*)(sw + s_ + ((pc) & 3) * 8192), 16, 0, 0); \
    else __builtin_amdgcn_global_load_lds((const unsigned*)(bp[((pc) - 4) % NBQ] + ko_), (unsigned*)(sw + s_ + 32768 + (((pc) - 4) % NBQ) * 8192), 16, 0, 0); } while (0)
  __syncthreads();
#pragma unroll
  for (int pc = 0; pc < 4 + NBQ; ++pc) GEMM_ISSUE1(0, pc);
#pragma unroll 1
  for (int kt = 0; kt < KS; ++kt) {
    WAIT_V(0);
    RAW_BARRIER();
    const bool more = kt + 1 < KS;
    const char* sa = smem + (kt & 1) * 65536;
    const char* sb = sa + 32768;
#pragma unroll
    for (int ks = 0; ks < 2; ++ks) {
      bf16x8 bfr[NJ];
#pragma unroll
      for (int j = 0; j < NJ; ++j) bfr[j] = *(const bf16x8*)(sb + wc * (NJ * 2048) + j * 2048 + (fb0 ^ (ks << 6)));
#pragma unroll
      for (int i = 0; i < 8; ++i) {
        bf16x8 af = *(const bf16x8*)(sa + wr * 16384 + i * 2048 + (fb0 ^ (ks << 6)));
        if (ks == 0 && i < 4 + NBQ) {
          __builtin_amdgcn_sched_barrier(0);
          if (more) GEMM_ISSUE1(kt + 1, i);
          __builtin_amdgcn_sched_barrier(0);
        }
#pragma unroll
        for (int j = 0; j < NJ; ++j) acc[i][j] = mfma16(af, bfr[j], acc[i][j]);
      }
    }
  }
#undef GEMM_ISSUE1

}

__device__ __forceinline__ void wtrans_tile(const float* W, int ldw, int k0, int n0src, u16* Wt, int n0dst, char* smem) {
  float(*tile)[65] = (float(*)[65])smem;
  const int t = VTID;
  __syncthreads();
#pragma unroll
  for (int i = 0; i < 16; ++i) {
    int kk = (t >> 6) + 4 * i, nn = t & 63;
    tile[kk][nn] = W[(long)(k0 + kk) * ldw + n0src + nn];
  }
  __syncthreads();
#pragma unroll
  for (int i = 0; i < 16; ++i) {
    int nn = (t >> 6) + 4 * i, kk = t & 63;
    Wt[blk(n0dst + nn, k0 + kk, 16)] = f2bf(tile[kk][nn]);
  }
}

__device__ __forceinline__ void phase_prep(const Params& p, char* smem) {
  const int t = VTID;
  u16* wt_even = (u16*)(p.ws + OFF_WT_EVEN);
  u16* wt_odd = (u16*)(p.ws + OFF_WT_ODD);
  u16* wt_out = (u16*)(p.ws + OFF_WT_OUT);
  float* modv = (float*)(p.ws + OFF_MOD);
  const int N_EVEN = 2048, N_ODDP = 1280, N_OUT = 1024, N_FOLD = 256, N_MOD = 384, N_BT = 240, N_DFT = 3, N_ROPE = 1;
  const int total = N_EVEN + N_ODDP + N_OUT + N_FOLD + N_MOD + N_BT + N_DFT + N_ROPE;
  for (int it = VBLK; it < total; it += VGRID) {
    int id = it;
    if (id < N_MOD) {
      int l = id / 96, jb = id % 96;
      float* sc = (float*)smem;
      float* red = (float*)(smem + 36864);
      __syncthreads();
      for (int idx = t; idx < 9 * 1024; idx += 256) {
        int r = idx >> 10, k = idx & 1023;
        float v = r < 8 ? p.c[r * 1024 + k] : p.c_ctx[k];
        sc[idx] = silu_f(v);
      }
      __syncthreads();
      int col = jb * 32 + (t & 31), kp = t >> 5;
      float a0 = 0, a1 = 0, a2 = 0, a3 = 0, a4 = 0, a5 = 0, a6 = 0, a7 = 0, a8 = 0;
      const float* wp = p.w_mod + ((long)l * 1024 + kp * 128) * 3072 + col;
      const float* sp = sc + kp * 128;
#pragma unroll 8
      for (int k = 0; k < 128; ++k) {
        float w = wp[(long)k * 3072];
        a0 += sp[k] * w; a1 += sp[1024 + k] * w; a2 += sp[2048 + k] * w; a3 += sp[3072 + k] * w;
        a4 += sp[4096 + k] * w; a5 += sp[5120 + k] * w; a6 += sp[6144 + k] * w; a7 += sp[7168 + k] * w;
        a8 += sp[8192 + k] * w;
      }
      float* rp = red + kp * 288 + (t & 31);
      rp[0] = a0; rp[32] = a1; rp[64] = a2; rp[96] = a3; rp[128] = a4; rp[160] = a5; rp[192] = a6; rp[224] = a7; rp[256] = a8;
      __syncthreads();
      for (int idx = t; idx < 288; idx += 256) {
        int r = idx >> 5, cc = idx & 31;
        float s = p.b_mod[l * 3072 + jb * 32 + cc];
#pragma unroll
        for (int q = 0; q < 8; ++q) s += red[q * 288 + r * 32 + cc];
        modv[(l * 9 + r) * 3072 + jb * 32 + cc] = s;
      }
      continue;
    }
    id -= N_MOD;
    if (id < N_EVEN) {
      int j = id >> 10, r = id & 1023, kt = r >> 6, nt = r & 63;
      wtrans_tile(p.w_in_even + (long)j * 1024 * 4096, 4096, kt * 64, nt * 64, wt_even + (long)j * 4096 * 1024, nt * 64, smem);
      continue;
    }
    id -= N_EVEN;
    if (id < N_ODDP) {
      int j = id / 640, r = id % 640, kt = r / 40, q = r % 40;
      int sec = q >> 3, nt = q & 7;
      int ssec = sec < 4 ? sec : 5;
      wtrans_tile(p.w_in_odd + (long)j * 1024 * 3072, 3072, kt * 64, ssec * 512 + nt * 64,
                  wt_odd + (long)j * 3584 * 1024, ssec * 512 + nt * 64, smem);
      continue;
    }
    id -= N_ODDP;
    if (id < N_OUT) {
      int l = id >> 8, r = id & 255, kt = r >> 4, nt = r & 15;
      wtrans_tile(p.w_out + (long)l * 1024 * 1024, 1024, kt * 64, nt * 64, wt_out + (long)l * 1024 * 1024, nt * 64, smem);
      continue;
    }
    id -= N_OUT;
    if (id < N_FOLD) {
      int j = id >> 7, r = id & 127, g = r >> 4, kb = r & 15;
      float(*u)[65] = (float(*)[65])smem;
      float* cosT = (float*)(smem + 64 * 65 * 4);
      float* sinT = cosT + 64;
      __syncthreads();
      const float* W = p.w_in_odd + (long)j * 1024 * 3072;
#pragma unroll
      for (int i = 0; i < 16; ++i) {
        int kk = (t >> 6) + 4 * i, cc = t & 63;
        u[kk][cc] = W[(long)(kb * 64 + kk) * 3072 + 2048 + g * 64 + cc];
      }
      if (t < 64) {
        float s, c;
        sincospif((float)t / 32.f, &s, &c);
        cosT[t] = c; sinT[t] = s;
      }
      __syncthreads();
      int kk = t & 63, cq = t >> 6;
      u16* dst = wt_odd + (long)j * 3584 * 1024;
      for (int c2 = cq * 16; c2 < cq * 16 + 16; ++c2) {
        float sr = 0.f, si = 0.f;
#pragma unroll 8
        for (int cc = 0; cc < 64; ++cc) {
          int idx = (cc * c2) & 63;
          float v = u[kk][cc];
          sr += v * cosT[idx];
          si -= v * sinT[idx];
        }
        dst[blk(4 * 512 + g * 64 + c2, kb * 64 + kk, 16)] = f2bf(sr);
        dst[blk(6 * 512 + g * 64 + c2, kb * 64 + kk, 16)] = f2bf(si);
      }
      continue;
    }
    id -= N_FOLD;
    if (id < N_BT) {
      int jh = id / 15, roff = id % 15;
      const float* src = p.rpb_c + (long)jh * 15 * 31 + roff * 31;
      float* dst = (float*)(p.ws + OFF_BT) + ((long)id * 256 + t) * 16;
      int w = t >> 6, lane = t & 63, lr = lane & 15, lg = lane >> 4;
      int qc = 16 * w + lr, cs = min(max(qc - 8, 0), 48);
#pragma unroll
      for (int k4 = 0; k4 < 4; ++k4) {
        f32x4 v;
#pragma unroll
        for (int e = 0; e < 4; ++e) {
          int kc = k4 * 16 + 4 * lg + e;
          bool valid = (kc >= cs) && (kc < cs + 16);
          v[e] = valid ? src[min(max(kc - qc + 15, 0), 30)] * LOG2E : -1e30f;
        }
        *(f32x4*)(dst + k4 * 4) = v;
      }
      continue;
    }
    id -= N_BT;
    if (id < N_DFT) {
      float* ct = (float*)smem;
      float* st = ct + 256;
      __syncthreads();
      if (id < 1) {
        u16* F1 = (u16*)(p.ws + OFF_FM1);
        u16* F2 = (u16*)(p.ws + OFF_FM2);
        float* TC = (float*)(p.ws + OFF_TWC);
        float* TS = (float*)(p.ws + OFF_TWS);
        if (t < 64) { float sn, cs; sincospif((float)t / 32.f, &sn, &cs); ct[t] = cs; st[t] = sn; }
        __syncthreads();
        for (int idx = t; idx < 128 * 128; idx += 256) {
          int row = idx >> 7, k = idx & 127;
          int rp = row >> 6, ap = row & 63, ri = k >> 6, a = k & 63;
          float cs = ct[(a * ap) & 63], sn = st[(a * ap) & 63];
          float v = (rp == 0) ? (ri == 0 ? cs : sn) : (ri == 0 ? -sn : cs);
          F1[idx] = f2bf(v);
        }
        for (int idx = t; idx < 64 * 128; idx += 256) {
          int bp = idx >> 7, k = idx & 127, ri = k >> 6, bb = k & 63;
          F2[idx] = f2bf(ri == 0 ? ct[(bb * bp) & 63] : st[(bb * bp) & 63]);
        }
        for (int idx = t; idx < 64 * 64; idx += 256) {
          int ap = idx >> 6, bb = idx & 63;
          float sn, cs;
          sincospif((float)(ap * bb) / 2048.f, &sn, &cs);
          TC[idx] = cs; TS[idx] = sn;
        }
      } else {
        u16* D = (u16*)(p.ws + OFF_DFTC);
        { float sn, cs; sincospif((float)t / 128.f, &sn, &cs); ct[t] = cs; st[t] = sn; }
        __syncthreads();
        for (int q = 0; q < 32; ++q) {
          int chunk = (id - 1) * 8192 + q * 256 + t;
          int row = chunk >> 6, col0 = (chunk & 63) * 8;
          int ri = col0 >> 8, n0 = col0 & 255;
          float v[8];
#pragma unroll
          for (int e = 0; e < 8; ++e) {
            int idx = (row * (n0 + e)) & 255;
            v[e] = ri ? st[idx] : ct[idx];
          }
          u32x4 o = {pack2(v[0], v[1]), pack2(v[2], v[3]), pack2(v[4], v[5]), pack2(v[6], v[7])};
          *(u32x4*)(D + blk(row, col0, 8)) = o;
        }
      }
      continue;
    }
    id -= N_DFT;
    {
      __syncthreads();
      __syncthreads();
      f32x2* tab = (f32x2*)(p.ws + OFF_ROPE);
      for (int i = t; i < 512; i += 256) {
        int pos = i >> 3, fi = i & 7;
        float inv = exp2f(-(float)fi * (13.287712379549449f / 8.f));
        float ang = (float)pos * inv;
        float s, c;
        sincospif(ang * 0.3183098861837907f, &s, &c);
        tab[i] = f32x2{c, s};
      }
      ((unsigned*)(p.ws + OFF_KMAX))[t] = 0u;
      if (t < 2) {
        const float* lp = p.lam_a + t * 128;
        float s1 = 0.f, s2 = 0.f;
#pragma unroll 1
        for (int i = 0; i < 32; ++i) { s1 += lp[i] * lp[32 + i]; s2 += lp[64 + i] * lp[96 + i]; }
        float lam_init = 0.8f - 0.6f * expf(-0.3f * (float)(2 * t));
        ((float*)(p.ws + OFF_LAM))[t] = expf(s1) - expf(s2) + lam_init;
      }
    }
  }
}

__device__ __forceinline__ void phase_rows(const Params& p, int l) {
  const int t = VTID, lane = t & 63, wave = t >> 6;
  const float* modv = (const float*)(p.ws + OFF_MOD);
  const u16* Y = (const u16*)(p.ws + OFF_PX);
  const float* SSQ = (const float*)(p.ws + OFF_SSQ);
  float* CS = (float*)(p.ws + OFF_CS);
  u16* H = (u16*)(p.ws + OFF_H);
  for (int it = VBLK; it < MTOT / 16; it += VGRID) {
    const int m0 = it * 16 + wave * 4;
    const int b = m0 / TPB, w0 = m0 - b * TPB;
    const bool isc = w0 < 256;
    if (l == 3 && isc) continue;
    const long srow0 = isc ? (long)(b * 256 + w0) : (long)(b * 4096 + w0 - 256);
    const float* xin0 = (l <= 0) ? ((isc ? p.ctx : p.x) + srow0 * 1024) : ((isc ? CS : p.out) + srow0 * 1024);
    float* xout0 = (isc ? CS : p.out) + srow0 * 1024;
    const int r = isc ? 8 : b;
    f32x4 xall[4][4];
    u32x2 yall[4][4];
    float ssall[4];
#pragma unroll
    for (int rr = 0; rr < 4; ++rr) {
#pragma unroll
      for (int i = 0; i < 4; ++i) xall[rr][i] = *(const f32x4*)(xin0 + rr * 1024 + lane * 4 + 256 * i);
      if (l >= 0) {
#pragma unroll
        for (int i = 0; i < 4; ++i) yall[rr][i] = *(const u32x2*)(Y + (long)(m0 + rr) * 1024 + lane * 4 + 256 * i);
        ssall[rr] = lane < 8 ? SSQ[(long)(m0 + rr) * 16 + lane] : 0.f;
      }
    }
#pragma unroll
    for (int rr = 0; rr < 4; ++rr) {
      const int m = m0 + rr;
      float* xout = xout0 + rr * 1024;
      f32x4 xv[4];
#pragma unroll
      for (int i = 0; i < 4; ++i) xv[i] = xall[rr][i];
      if (l >= 0) {
        float ss = ssall[rr];
#pragma unroll
        for (int o = 1; o < 64; o <<= 1) ss += __shfl_xor(ss, o);
        float rstd = rsqrtf(ss * (1.f / 1024.f) + EPS);
        const float* gp = modv + (l * 9 + r) * 3072 + 2048;
        const float* np = p.norm_post + l * 1024;
#pragma unroll
        for (int i = 0; i < 4; ++i) {
          int k = lane * 4 + 256 * i;
          u32x2 yb = yall[rr][i];
          f32x4 y = {bf2f(yb.x & 0xffff), bf2f(yb.x >> 16), bf2f(yb.y & 0xffff), bf2f(yb.y >> 16)};
          f32x4 g = *(const f32x4*)(gp + k);
          f32x4 n = *(const f32x4*)(np + k);
          xv[i].x += g.x * (y.x * rstd * n.x);
          xv[i].y += g.y * (y.y * rstd * n.y);
          xv[i].z += g.z * (y.z * rstd * n.z);
          xv[i].w += g.w * (y.w * rstd * n.w);
          *(f32x4*)(xout + k) = xv[i];
        }
      }
      if (l < 3) {
        int ln = l + 1;
        float ss = 0.f;
#pragma unroll
        for (int i = 0; i < 4; ++i) ss += xv[i].x * xv[i].x + xv[i].y * xv[i].y + xv[i].z * xv[i].z + xv[i].w * xv[i].w;
#pragma unroll
        for (int o = 1; o < 64; o <<= 1) ss += __shfl_xor(ss, o);
        float rstd = rsqrtf(ss * (1.f / 1024.f) + EPS);
        const float* mp = modv + (ln * 9 + r) * 3072;
        const float* np = p.norm_pre + ln * 1024;
#pragma unroll
        for (int i = 0; i < 4; ++i) {
          int k = lane * 4 + 256 * i;
          f32x4 sh = *(const f32x4*)(mp + k);
          f32x4 sc = *(const f32x4*)(mp + 1024 + k);
          f32x4 n = *(const f32x4*)(np + k);
          float h0 = xv[i].x * rstd * n.x * (1.f + sc.x) + sh.x;
          float h1 = xv[i].y * rstd * n.y * (1.f + sc.y) + sh.y;
          float h2 = xv[i].z * rstd * n.z * (1.f + sc.z) + sh.z;
          float h3 = xv[i].w * rstd * n.w * (1.f + sc.w) + sh.w;
          u32x2 o = {pack2(h0, h1), pack2(h2, h3)};
          *(u32x2*)(H + blk(m, k, 16)) = o;
        }
      }
    }
  }
}

template <bool NOSTORE = false>
__device__ __forceinline__ void phase_proj(const Params& p, int l, char* smem) {
  const int t = threadIdx.x, lane = t & 63, wave = t >> 6;
  const int wr = wave >> 2, wc = wave & 3, lr = lane & 15, lg = lane >> 4;
  const bool even = (l & 1) == 0;
  const int j = l >> 1;
  const u16* H = (const u16*)(p.ws + OFF_H);
  const u16* Wt = even ? (const u16*)(p.ws + OFF_WT_EVEN) + (long)j * 4096 * 1024
                       : (const u16*)(p.ws + OFF_WT_ODD) + (long)j * 3584 * 1024;
  u16* PX = (u16*)(p.ws + OFF_PX);
  u16* VT = (u16*)(p.ws + OFF_VT);
  u16* ZT = (u16*)(p.ws + OFF_ZT);
  u16* ZTC = (u16*)(p.ws + OFF_ZTC);
  const f32x2* rope = (const f32x2*)(p.ws + OFF_ROPE);
  const int pitch = even ? 3584 : 2048;
  const int NWN = even ? 14 : 8;
  const int NWT = even ? 2 : 6;
  const int n_normal = 136 * NWN, total = n_normal + 136 * NWT;
  for (int it = blockIdx.x; it < total; it += gridDim.x) {
    const bool trans = it >= n_normal;
    int b, sec, sc0, tw;
    if (!trans) {
      int tt = it % 136, wt = it / 136;
      b = tt / 17; tw = tt % 17;
      int sidx = wt >> 1;
      sec = even ? (sidx < 2 ? sidx : sidx + 1) : (sidx < 2 ? sidx : (sidx == 2 ? 3 : 5));
      sc0 = (wt & 1) * 256;
    } else {
      int it2 = it - n_normal;
      int tt = it2 / NWT, wt = it2 % NWT;
      b = tt / 17; tw = tt % 17;
      sec = even ? 2 : 2 + 2 * (wt >> 1);
      sc0 = (wt & 1) * 256;
    }
    const bool isc = tw == 0;
    if (l == 3 && isc && !(sec == 1 || sec == 2)) continue;
    f32x4 acc[8][4];
    const long rowW = (long)sec * 512 + sc0;
    const long rowH = (long)b * TPB + tw * 256;
    const bool zperm = trans && sec != 2 && !isc;
    gemm_core<4>(trans ? H : Wt, trans ? (zperm ? (long)(b * TPB + 256) : rowH) : rowW, trans ? Wt : H, trans ? rowW : rowH, 1024, acc, smem,
                 zperm ? tw - 1 : -1);
    if (NOSTORE) {
      float ss = 0.f;
#pragma unroll
      for (int i = 0; i < 8; ++i)
#pragma unroll
        for (int jj = 0; jj < 4; ++jj) ss += acc[i][jj][0] + acc[i][jj][1] + acc[i][jj][2] + acc[i][jj][3];
      if (ss == 12345.678f) PX[t] = 0;
      continue;
    }
    __syncthreads();
    char* wreg = smem + wave * 16384;
    const bool do_rope = !trans && even && sec < 2 && !isc;
#pragma unroll
    for (int jj = 0; jj < 4; ++jj)
#pragma unroll
      for (int i = 0; i < 8; ++i) {
        u32x2 o = {pack2(acc[i][jj][0], acc[i][jj][1]), pack2(acc[i][jj][2], acc[i][jj][3])};
        int c8 = i * 4 + lg;
        if (trans && sec == 2) c8 = (c8 & ~7) | ((c8 & 3) << 1) | ((c8 >> 2) & 1);
        *(u32x2*)(wreg + (jj * 16 + lr) * 256 + ((c8 ^ (lr << 1)) << 3)) = o;
      }
    __syncthreads();
    int pxcol;
    if (even) pxcol = sec < 2 ? sec * 512 : (sec - 1) * 512;
    else pxcol = sec == 0 ? 0 : sec == 1 ? 512 : sec == 3 ? 1024 : 1536;
    const bool knorm = !trans && even && sec == 1;
    float kmx = 0.f;
#pragma unroll 2
    for (int n = 0; n < 16; ++n) {
      int row = n * 4 + lg, k = lr;
      u32x4 v = *(const u32x4*)(wreg + row * 256 + ((k ^ (row & 15)) << 4));
      if (!trans) {
        long m = (long)b * TPB + tw * 256 + wc * 64 + row;
        if (do_rope) {
          u32x4 w = *(const u32x4*)(wreg + row * 256 + (((k ^ 1) ^ (row & 15)) << 4));
          int tl = tw * 256 - 256 + wc * 64 + row;
          int pos = ((k >> 1) & 1) ? (tl & 63) : (tl >> 6);
          const f32x4* rp = (const f32x4*)(rope + pos * 8);
          const float sg = (k & 1) ? 1.f : -1.f;
          u32x4 r;
#pragma unroll
          for (int e = 0; e < 4; ++e) {
            f32x4 cs = rp[e];
            float a0 = bf2f(v[e] & 0xffff), a1 = bf2f(v[e] >> 16), o0 = bf2f(w[e] & 0xffff), o1 = bf2f(w[e] >> 16);
            r[e] = pack2(a0 * cs[0] + sg * o0 * cs[1], a1 * cs[2] + sg * o1 * cs[3]);
          }
          v = r;
        }
        if (knorm) {
          float ssq = 0.f;
#pragma unroll
          for (int e = 0; e < 4; ++e) { float a0 = bf2f(v[e] & 0xffff), a1 = bf2f(v[e] >> 16); ssq += a0 * a0 + a1 * a1; }
          ssq += __shfl_xor(ssq, 1);
          ssq += __shfl_xor(ssq, 2);
          kmx = fmaxf(kmx, ssq);
        }
        *(u32x4*)(PX + m * pitch + pxcol + sc0 + wr * 128 + k * 8) = v;
      } else {
        int wcol = sc0 + wc * 64 + row;
        int tk = k * 8;
        if (sec == 2) {
          int h = wcol >> 6, d = wcol & 63;
          *(u32x4*)(VT + ((long)((b * 8 + h) * 64 + d)) * TPB + tw * 256 + wr * 128 + tk) = v;
        } else {
          int ri = sec == 6 ? 1 : 0;
          if (isc) *(u32x4*)(ZTC + blk(b * 512 + wcol, ri * 256 + wr * 128 + tk, 8)) = v;
          else     *(u32x4*)(ZT + ((long)((b * 512 + wcol) * 2 + ri)) * 4096 + (4 * (tw - 1) + wr * 2) * 64 + tk) = v;
        }
      }
    }
    if (knorm) {
      kmx = fmaxf(kmx, __shfl_xor(kmx, 16));
      kmx = fmaxf(kmx, __shfl_xor(kmx, 32));
      if (lg == 0 && (lr & 3) == 0) {
        int col = sc0 + wr * 128 + lr * 8;
        atomicMax((unsigned*)(p.ws + OFF_KMAX) + ((j * 8 + b) * 8 + (col >> 6)) * 2 + ((col >> 5) & 1), __float_as_uint(kmx));
      }
    }
  }
}

__device__ __forceinline__ void ld_tile64(const u16* base, long pitch, u32x4 (&r)[2]) {
  const int t = VTID, c = t & 7, r0 = t >> 3;
  r[0] = *(const u32x4*)(base + (long)r0 * pitch + c * 8);
  r[1] = *(const u32x4*)(base + (long)(r0 + 32) * pitch + c * 8);
}
__device__ __forceinline__ void st_tile64(char* s, const u32x4 (&r)[2]) {
  const int t = VTID, c = t & 7, r0 = t >> 3;
  *(u32x4*)(s + swz(r0, c)) = r[0];
  *(u32x4*)(s + swz(r0 + 32, c)) = r[1];
}
__device__ __forceinline__ bf16x8 ld_vfrag(const char* sV, int vb, int dt, int ks) {
  return *(const bf16x8*)(sV + dt * 2048 + (vb ^ (ks << 6)));
}

#define NQT 2
__device__ __forceinline__ void diff_attn_item(const Params& p, int l, int b, int h, int q0, int nkeys, char* smem) {
  const int t = VTID, lane = t & 63, wave = t >> 6, lr = lane & 15, lg = lane >> 4;
  const int j = l >> 1;
  const u16* PX = (const u16*)(p.ws + OFF_PX);
  const u16* VT = (const u16*)(p.ws + OFF_VT);
  u16* MX = (u16*)(p.ws + OFF_H);
  const int pitch = 3584;
  const float cexp = 0.17677669529663687f * LOG2E;
  const int kx = (lr >> 1) & 7;
  const int kb0 = lr * 128 + ((lg ^ kx) << 4);
  const int vb = kb0;
  int opq = 0;
  asm volatile("" : "+s"(opq));
  smem += opq;
  const float lam = ((const float*)(p.ws + OFF_LAM))[j + opq];
  const float one_m_li = 1.f - (0.8f - 0.6f * expf(-0.3f * (float)l));
  const long rowbase = (long)b * TPB;
  bf16x8 Q[2][NQT];
#pragma unroll
  for (int m = 0; m < 2; ++m)
#pragma unroll
    for (int qt = 0; qt < NQT; ++qt)
      Q[m][qt] = *(const bf16x8*)(PX + (rowbase + q0 + wave * (16 * NQT) + qt * 16 + lr) * pitch + h * 64 + m * 32 + lg * 8);
  f32x4 O[2][NQT][4], Ls[2][NQT];
  float Mx[2][NQT];
#pragma unroll
  for (int m = 0; m < 2; ++m) {
    const float kmax2 = __uint_as_float(((const unsigned*)(p.ws + OFF_KMAX))[((j * 8 + b) * 8 + h) * 2 + m + opq]);
#pragma unroll
    for (int qt = 0; qt < NQT; ++qt) {
      u32x4 qu = __builtin_bit_cast(u32x4, Q[m][qt]);
      float qs = 0.f;
#pragma unroll
      for (int e = 0; e < 4; ++e) { float a0 = bf2f(qu[e] & 0xffff), a1 = bf2f(qu[e] >> 16); qs += a0 * a0 + a1 * a1; }
      qs += __shfl_xor(qs, 16);
      qs += __shfl_xor(qs, 32);
      Mx[m][qt] = sqrtf(qs * kmax2) * (cexp * 1.001f) + 1e-3f - 32.f;
      Ls[m][qt] = f32x4{0.f, 0.f, 0.f, 0.f};
#pragma unroll
      for (int dt = 0; dt < 4; ++dt) O[m][qt][dt] = f32x4{0.f, 0.f, 0.f, 0.f};
    }
  }
  const u32x4 ones_u = {0x3F803F80u, 0x3F803F80u, 0x3F803F80u, 0x3F803F80u};
  const bf16x8 ones = __builtin_bit_cast(bf16x8, ones_u);
  const u16* kbase = PX + rowbase * pitch + 512 + h * 64;
  const u16* vbase = VT + (long)((b * 8 + h) * 64) * TPB;
  const u16* kp[2];
  const u16* vp[2];
#pragma unroll
  for (int q = 0; q < 2; ++q) {
    int R = (q * 4 + wave) * 8 + (lane >> 3);
    int cl = (lane & 7) ^ ((R >> 1) & 7);
    kp[q] = kbase + (long)R * pitch + cl * 8;
    vp[q] = vbase + (long)R * TPB + cl * 8;
  }
  char* sw = smem + wave * 1024;
#define ATT_ISSUE(kt) do { const int s_ = ((kt) & 3) * 16384; \
    __builtin_amdgcn_global_load_lds((const unsigned*)(kp[0] + (long)(kt) * 64 * pitch), (unsigned*)(sw + s_), 16, 0, 0); \
    __builtin_amdgcn_global_load_lds((const unsigned*)(kp[1] + (long)(kt) * 64 * pitch), (unsigned*)(sw + s_ + 4096), 16, 0, 0); \
    __builtin_amdgcn_global_load_lds((const unsigned*)(vp[0] + (kt) * 64), (unsigned*)(sw + s_ + 8192), 16, 0, 0); \
    __builtin_amdgcn_global_load_lds((const unsigned*)(vp[1] + (kt) * 64), (unsigned*)(sw + s_ + 12288), 16, 0, 0); } while (0)
  const int nkt = nkeys >> 6;
  __syncthreads();
  ATT_ISSUE(0);
  ATT_ISSUE(1);
  ATT_ISSUE(2);
#pragma unroll 4
  for (int kt = 0; kt < nkt; ++kt) {
    if (kt + 2 < nkt) WAIT_V(8);
    else if (kt + 1 < nkt) WAIT_V(4);
    else WAIT_V(0);
    RAW_BARRIER();
    const char* sK = smem + (kt & 3) * 16384;
    const char* sV = sK + 8192;
#pragma unroll
    for (int m = 0; m < 2; ++m) {
      f32x4 S[NQT][4];
#pragma unroll
      for (int k4 = 0; k4 < 4; ++k4) {
        bf16x8 kf = *(const bf16x8*)(sK + k4 * 2048 + (kb0 ^ (m << 6)));
#pragma unroll
        for (int qt = 0; qt < NQT; ++qt) S[qt][k4] = mfma16(kf, Q[m][qt], f32x4{0.f, 0.f, 0.f, 0.f});
      }
      if (m == 0 && kt + 3 < nkt) ATT_ISSUE(kt + 3);
      bf16x8 P[NQT][2];
#pragma unroll
      for (int qt = 0; qt < NQT; ++qt) {
        const float mref = Mx[m][qt];
#pragma unroll
        for (int k4 = 0; k4 < 4; ++k4) {
          f32x4 a4 = S[qt][k4] * cexp - mref;
#pragma unroll
          for (int e = 0; e < 4; ++e) S[qt][k4][e] = fexp2(a4[e]);
        }
#pragma unroll
        for (int ks = 0; ks < 2; ++ks) {
          u32x4 pu = {pack2(S[qt][2 * ks][0], S[qt][2 * ks][1]), pack2(S[qt][2 * ks][2], S[qt][2 * ks][3]),
                      pack2(S[qt][2 * ks + 1][0], S[qt][2 * ks + 1][1]), pack2(S[qt][2 * ks + 1][2], S[qt][2 * ks + 1][3])};
          P[qt][ks] = __builtin_bit_cast(bf16x8, pu);
        }
      }
#pragma unroll
      for (int ks = 0; ks < 2; ++ks)
#pragma unroll
        for (int qt = 0; qt < NQT; ++qt) Ls[m][qt] = mfma16(ones, P[qt][ks], Ls[m][qt]);
#pragma unroll
      for (int dt = 0; dt < 4; ++dt)
#pragma unroll
        for (int ks = 0; ks < 2; ++ks) {
          bf16x8 vf = ld_vfrag(sV, vb, dt, ks);
#pragma unroll
          for (int qt = 0; qt < NQT; ++qt) O[m][qt][dt] = mfma16(vf, P[qt][ks], O[m][qt][dt]);
        }
    }
  }
#undef ATT_ISSUE
  const float* sub = p.subln_a + j * 64 + opq;
#pragma unroll
  for (int qt = 0; qt < NQT; ++qt) {
    float l0 = Ls[0][qt][0], l1 = Ls[1][qt][0];
    float i0 = 1.f / l0, i1 = lam / l1;
    float ss = 0.f;
    f32x4 o[4];
#pragma unroll
    for (int dt = 0; dt < 4; ++dt) {
#pragma unroll
      for (int e = 0; e < 4; ++e) {
        float v = O[0][qt][dt][e] * i0 - O[1][qt][dt][e] * i1;
        o[dt][e] = v;
        ss += v * v;
      }
    }
    ss += __shfl_xor(ss, 16); ss += __shfl_xor(ss, 32);
    float rstd = rsqrtf(ss * (1.f / 64.f) + EPS) * one_m_li;
    long m = rowbase + q0 + wave * (16 * NQT) + qt * 16 + lr;
#pragma unroll
    for (int dt = 0; dt < 4; ++dt) {
      int d = dt * 16 + 4 * lg;
      u32x2 gg = *(const u32x2*)(PX + m * pitch + 1024 + h * 64 + d);
      f32x4 sw = *(const f32x4*)(sub + d);
      float g0 = bf2f(gg.x & 0xffff), g1 = bf2f(gg.x >> 16), g2 = bf2f(gg.y & 0xffff), g3 = bf2f(gg.y >> 16);
      float r0 = o[dt][0] * rstd * sw.x * silu_f(g0);
      float r1 = o[dt][1] * rstd * sw.y * silu_f(g1);
      float r2 = o[dt][2] * rstd * sw.z * silu_f(g2);
      float r3 = o[dt][3] * rstd * sw.w * silu_f(g3);
      u32x2 ov = {pack2(r0, r1), pack2(r2, r3)};
      *(u32x2*)(MX + blk(m, h * 64 + d, 16)) = ov;
    }
  }
}

__device__ __forceinline__ void conv_item(const Params& p, int l, int item) {
  const int t = VTID;
  const int j = l >> 1;
  const u16* PX = (const u16*)(p.ws + OFF_PX);
  u16* MX = (u16*)(p.ws + OFF_H);
  const int pitch = 3584;
  const int col = (t & 63) * 8, rsub = t >> 6;
  float w0[8], w1[8], w2[8];
  int opq = 0;
  asm volatile("" : "+s"(opq));
  const float* cw = p.conv_b + j * 3 * 512 + opq;
#pragma unroll
  for (int e = 0; e < 8; ++e) { w0[e] = cw[col + e]; w1[e] = cw[512 + col + e]; w2[e] = cw[1024 + col + e]; }
  for (int ps = 0; ps < 8; ++ps) {
    long m = (long)item * 32 + ps * 4 + rsub;
    int w = (int)(m % TPB);
    bool hp = (w != 0) && (w != 256), hn = (w != 255) && (w != TPB - 1);
    const u16* row = PX + m * pitch;
    u32x4 zero = {0, 0, 0, 0};
    u32x4 c1 = *(const u32x4*)(row + 2048 + col), u1 = *(const u32x4*)(row + 2560 + col);
    u32x4 c0 = hp ? *(const u32x4*)(row - pitch + 2048 + col) : zero, u0 = hp ? *(const u32x4*)(row - pitch + 2560 + col) : zero;
    u32x4 c2 = hn ? *(const u32x4*)(row + pitch + 2048 + col) : zero, u2 = hn ? *(const u32x4*)(row + pitch + 2560 + col) : zero;
    u32x4 bb = *(const u32x4*)(row + 1536 + col), gb = *(const u32x4*)(row + 3072 + col);
    const unsigned* pc0 = (const unsigned*)&c0; const unsigned* pu0 = (const unsigned*)&u0;
    const unsigned* pc1 = (const unsigned*)&c1; const unsigned* pu1 = (const unsigned*)&u1;
    const unsigned* pc2 = (const unsigned*)&c2; const unsigned* pu2 = (const unsigned*)&u2;
    const unsigned* pb = (const unsigned*)&bb; const unsigned* pg = (const unsigned*)&gb;
    float r[8];
#pragma unroll
    for (int e = 0; e < 8; ++e) {
      int sh = (e & 1) * 16, q = e >> 1;
      float z0 = bf2f((pc0[q] >> sh) & 0xffff) * bf2f((pu0[q] >> sh) & 0xffff);
      float z1 = bf2f((pc1[q] >> sh) & 0xffff) * bf2f((pu1[q] >> sh) & 0xffff);
      float z2 = bf2f((pc2[q] >> sh) & 0xffff) * bf2f((pu2[q] >> sh) & 0xffff);
      float y = z0 * w0[e] + z1 * w1[e] + z2 * w2[e];
      r[e] = bf2f((pb[q] >> sh) & 0xffff) * y * silu_f(bf2f((pg[q] >> sh) & 0xffff));
    }
    u32x4 o = {pack2(r[0], r[1]), pack2(r[2], r[3]), pack2(r[4], r[5]), pack2(r[6], r[7])};
    *(u32x4*)(MX + blk(m, 512 + col, 16)) = o;
  }
}

__device__ __forceinline__ void phase_mix_even(const Params& p, int l, char* smem) {
  const int QB = 64 * NQT;
  const int NQB = 4096 / QB, NCB = 256 / QB;
  const int N_ATT = 64 * NQB, N_CATT = 64 * NCB, N_CONV = MTOT / 32;
  for (int it = VBLK; it < N_ATT + N_CATT; it += VGRID) {
    int id = it;
    int b, h, q0, nkeys;
    if (id < N_ATT) { int bh = id / NQB; b = bh >> 3; h = bh & 7; q0 = 256 + (id % NQB) * QB; nkeys = TPB; }
    else { id -= N_ATT; int bh = id / NCB; b = bh >> 3; h = bh & 7; q0 = (id % NCB) * QB; nkeys = 256; }
    diff_attn_item(p, l, b, h, q0, nkeys, smem);
  }
  for (int it = (VBLK + VGRID - (N_CATT % VGRID)) % VGRID; it < N_CONV; it += VGRID) conv_item(p, l, it);
}

#define NQR 2
__device__ __forceinline__ void na_item(const Params& p, int l, int b, int h, int rg, bool win, char* smem) {
  const int t = VTID, lane = t & 63, wave = t >> 6, lr = lane & 15, lg = lane >> 4;
  const int j = l >> 1;
  const u16* PX = (const u16*)(p.ws + OFF_PX);
  const u16* VT = (const u16*)(p.ws + OFF_VT);
  u16* MX = (u16*)(p.ws + OFF_H);
  const int pitch = 2048;
  const float cexp = 0.125f * LOG2E;
  const int kx = (lr >> 1) & 7;
  const int kb0 = lr * 128 + ((lg ^ kx) << 4);
  const int vb = kb0;
  const long rowbase = (long)b * TPB;
  const int r0 = rg * NQR;
  const int ulo = win ? min(max(r0 - 4, 0), 56) : 0;
  const int nU = win ? (min(max(r0 + NQR - 5, 0), 56) + 7 - ulo + 1) : 0;
  const int ntile = nU + 4;
  int opq = 0;
  asm volatile("" : "+s"(opq));
  smem += opq;
  __syncthreads();
  const float* BT = (const float*)(p.ws + OFF_BT) + ((long)(j * 8 + h) * 15 * 256 + t) * 16;
  bf16x8 Q[NQR][2];
  const long mrow0 = rowbase + (win ? 256 : 0) + r0 * 64 + wave * 16 + lr;
#pragma unroll
  for (int qr = 0; qr < NQR; ++qr) {
#pragma unroll
    for (int ks = 0; ks < 2; ++ks) Q[qr][ks] = *(const bf16x8*)(PX + (mrow0 + 64 * qr) * pitch + h * 64 + ks * 32 + lg * 8);
  }
  f32x4 O[NQR][4], Ls[NQR];
  float Mx[NQR];
#pragma unroll
  for (int qr = 0; qr < NQR; ++qr) {
    Mx[qr] = -1e30f; Ls[qr] = f32x4{0.f, 0.f, 0.f, 0.f};
#pragma unroll
    for (int dt = 0; dt < 4; ++dt) O[qr][dt] = f32x4{0.f, 0.f, 0.f, 0.f};
  }
  const u32x4 ones_u = {0x3F803F80u, 0x3F803F80u, 0x3F803F80u, 0x3F803F80u};
  const bf16x8 ones = __builtin_bit_cast(bf16x8, ones_u);
  const u16* kbase = PX + rowbase * pitch + 512 + h * 64;
  const u16* vbase = VT + (long)((b * 8 + h) * 64) * TPB;
  auto keybase = [&](int tt) { return tt < nU ? 256 + (ulo + tt) * 64 : (tt - nU) * 64; };
  u32x4 rk[2], rv[2];
  {
    int kb = keybase(0);
    ld_tile64(kbase + (long)kb * pitch, pitch, rk);
    ld_tile64(vbase + kb, TPB, rv);
  }
  st_tile64(smem, rk);
  st_tile64(smem + 8192, rv);
  __syncthreads();
  const int qc = wave * 16 + lr;
  const int cs = min(max(qc - 8, 0), 48);
  const int k4lo = max(wave - 1, 0), k4hi = min(wave + 1, 3);
  for (int tt = 0; tt < NQR + 11; ++tt) {
    if (tt >= ntile) { __syncthreads(); continue; }
    const char* sK = smem + (tt & 1) * 16384;
    const char* sV = sK + 8192;
    if (tt + 1 < ntile) {
      int kb = keybase(tt + 1);
      ld_tile64(kbase + (long)kb * pitch, pitch, rk);
      ld_tile64(vbase + kb, TPB, rv);
    }
    const bool wt = tt < nU;
    const int u = ulo + tt;
#pragma unroll
    for (int qr = 0; qr < NQR; ++qr) {
      const int r = r0 + qr;
      const int rs = min(max(r - 4, 0), 56);
      if (wt && (u < rs || u > rs + 7)) continue;
      f32x4 S[4];
#pragma unroll
      for (int k4 = 0; k4 < 4; ++k4) {
        if (!wt || (k4 >= k4lo && k4 <= k4hi)) {
          S[k4] = mfma16(*(const bf16x8*)(sK + k4 * 2048 + kb0), Q[qr][0], f32x4{0.f, 0.f, 0.f, 0.f});
          S[k4] = mfma16(*(const bf16x8*)(sK + k4 * 2048 + (kb0 ^ 64)), Q[qr][1], S[k4]);
        } else {
          S[k4] = f32x4{-1e30f, -1e30f, -1e30f, -1e30f};
        }
      }
      if (wt) {
        const int roff = u - r + 7;
        const f32x4* bt = (const f32x4*)(BT + roff * 4096);
#pragma unroll
        for (int k4 = 0; k4 < 4; ++k4) {
          if (k4 >= k4lo && k4 <= k4hi) S[k4] = S[k4] * cexp + bt[k4];
        }
      } else {
#pragma unroll
        for (int k4 = 0; k4 < 4; ++k4) S[k4] *= cexp;
      }
      float mx = fmaxf(fmaxf(S[0][0], S[0][1]), fmaxf(S[0][2], S[0][3]));
#pragma unroll
      for (int k4 = 1; k4 < 4; ++k4) mx = fmaxf(fmaxf(mx, S[k4][0]), fmaxf(fmaxf(S[k4][1], S[k4][2]), S[k4][3]));
      if (__builtin_amdgcn_ballot_w64(mx > Mx[qr] + 8.f) != 0) {
        mx = fmaxf(mx, __shfl_xor(mx, 16));
        mx = fmaxf(mx, __shfl_xor(mx, 32));
        float mnew = fmaxf(Mx[qr], mx);
        float alpha = fexp2(Mx[qr] - mnew);
        Mx[qr] = mnew;
#pragma unroll
        for (int dt = 0; dt < 4; ++dt) O[qr][dt] *= alpha;
        Ls[qr] *= alpha;
      }
      const float mref = Mx[qr];
#pragma unroll
      for (int k4 = 0; k4 < 4; ++k4)
#pragma unroll
        for (int e = 0; e < 4; ++e) S[k4][e] = fexp2(S[k4][e] - mref);
#pragma unroll
      for (int ks = 0; ks < 2; ++ks) {
        u32x4 pu = {pack2(S[2 * ks][0], S[2 * ks][1]), pack2(S[2 * ks][2], S[2 * ks][3]),
                    pack2(S[2 * ks + 1][0], S[2 * ks + 1][1]), pack2(S[2 * ks + 1][2], S[2 * ks + 1][3])};
        bf16x8 pf = __builtin_bit_cast(bf16x8, pu);
        Ls[qr] = mfma16(ones, pf, Ls[qr]);
#pragma unroll
        for (int dt = 0; dt < 4; ++dt) O[qr][dt] = mfma16(ld_vfrag(sV, vb, dt, ks), pf, O[qr][dt]);
      }
    }
    if (tt + 1 < ntile) {
      char* ns = smem + ((tt + 1) & 1) * 16384;
      st_tile64(ns, rk);
      st_tile64(ns + 8192, rv);
    }
    __syncthreads();
  }
#pragma unroll
  for (int qr = 0; qr < NQR; ++qr) {
    float inv = 1.f / Ls[qr][0];
#pragma unroll
    for (int dt = 0; dt < 4; ++dt) {
      int d = dt * 16 + 4 * lg;
      u32x2 gg = *(const u32x2*)(PX + (mrow0 + 64 * qr) * pitch + 1024 + h * 64 + d);
      float g0 = bf2f(gg.x & 0xffff), g1 = bf2f(gg.x >> 16), g2 = bf2f(gg.y & 0xffff), g3 = bf2f(gg.y >> 16);
      u32x2 ov = {pack2(O[qr][dt][0] * inv * silu_f(g0), O[qr][dt][1] * inv * silu_f(g1)),
                  pack2(O[qr][dt][2] * inv * silu_f(g2), O[qr][dt][3] * inv * silu_f(g3))};
      *(u32x2*)(MX + blk(mrow0 + 64 * qr, h * 64 + d, 16)) = ov;
    }
  }
}

__device__ __forceinline__ void fourier_ctx_tile(const Params& p, int b, int nt, char* smem) {
  const int t = threadIdx.x, lane = t & 63, wave = t >> 6;
  const int wr = wave >> 2, wc = wave & 3, lr = lane & 15, lg = lane >> 4;
  const u16* PX = (const u16*)(p.ws + OFF_PX);
  u16* MX = (u16*)(p.ws + OFF_H);
  f32x4 acc[8][4];
  const u16* Ad = (const u16*)(p.ws + OFF_DFTC);
  const u16* Bz = (const u16*)(p.ws + OFF_ZTC);
  const float scale = 1.f / 128.f;
  const long mbase = (long)b * TPB;
  gemm_core<4>(Bz, (long)(b * 512 + nt * 256), Ad, 0, 512, acc, smem);
#pragma unroll
  for (int jj = 0; jj < 4; ++jj) {
    long m = mbase + wc * 64 + jj * 16 + lr;
#pragma unroll
    for (int i = 0; i < 8; ++i) {
      int col = nt * 256 + wr * 128 + i * 16 + 4 * lg;
      u32x2 gg = *(const u32x2*)(PX + m * 2048 + 1536 + col);
      float g0 = bf2f(gg.x & 0xffff), g1 = bf2f(gg.x >> 16), g2 = bf2f(gg.y & 0xffff), g3 = bf2f(gg.y >> 16);
      u32x2 ov = {pack2(acc[i][jj][0] * scale * silu_f(g0), acc[i][jj][1] * scale * silu_f(g1)),
                  pack2(acc[i][jj][2] * scale * silu_f(g2), acc[i][jj][3] * scale * silu_f(g3))};
      *(u32x2*)(MX + blk(m, 512 + col, 16)) = ov;
    }
  }
}

__device__ __forceinline__ void fft_stage1_item(const Params& p, int b, int colp) {
  const int t = VTID, lane = t & 63, wave = t >> 6, lr = lane & 15, lg = lane >> 4;
  const u16* F1 = (const u16*)(p.ws + OFF_FM1);
  const float* TC = (const float*)(p.ws + OFF_TWC);
  const float* TS = (const float*)(p.ws + OFF_TWS);
  u16* TG = (u16*)(p.ws + OFF_TG);
  const int ap = 16 * wave + lr;
  bf16x8 yf[2][4];
#pragma unroll
  for (int rp = 0; rp < 2; ++rp)
#pragma unroll
    for (int ks = 0; ks < 4; ++ks) yf[rp][ks] = *(const bf16x8*)(F1 + (rp * 64 + ap) * 128 + ks * 32 + lg * 8);
  bf16x8 xf[2][4][4];
#pragma unroll
  for (int c = 0; c < 2; ++c) {
    const u16* Z = (const u16*)(p.ws + OFF_ZT) + (long)(b * 512 + colp * 2 + c) * 8192;
#pragma unroll
    for (int i = 0; i < 4; ++i)
#pragma unroll
      for (int ks = 0; ks < 4; ++ks)
        xf[c][i][ks] = *(const bf16x8*)(Z + (ks >> 1) * 4096 + (16 * i + lr) * 64 + (ks & 1) * 32 + lg * 8);
  }
#pragma unroll
  for (int c = 0; c < 2; ++c) {
    const int col = colp * 2 + c;
    u16* dst = TG + ((long)(b * 64 + ap) * 512 + col) * 128;
#pragma unroll
    for (int i = 0; i < 4; ++i) {
      f32x4 tr = f32x4{0.f, 0.f, 0.f, 0.f}, ti = f32x4{0.f, 0.f, 0.f, 0.f};
#pragma unroll
      for (int ks = 0; ks < 4; ++ks) {
        tr = mfma16(xf[c][i][ks], yf[0][ks], tr);
        ti = mfma16(xf[c][i][ks], yf[1][ks], ti);
      }
      int bb0 = 16 * i + 4 * lg;
      f32x4 tc = *(const f32x4*)(TC + ap * 64 + bb0);
      f32x4 ts = *(const f32x4*)(TS + ap * 64 + bb0);
      f32x4 nr = tr * tc + ti * ts;
      f32x4 ni = ti * tc - tr * ts;
      u32x2 o0 = {pack2(nr[0], nr[1]), pack2(nr[2], nr[3])};
      u32x2 o1 = {pack2(ni[0], ni[1]), pack2(ni[2], ni[3])};
      *(u32x2*)(dst + bb0) = o0;
      *(u32x2*)(dst + 64 + bb0) = o1;
    }
  }
}

__device__ __forceinline__ void fft_stage2_item(const Params& p, int b, int ap, int ct) {
  const int t = VTID, lane = t & 63, wave = t >> 6, lr = lane & 15, lg = lane >> 4;
  const u16* T = (const u16*)(p.ws + OFF_TG) + ((long)(b * 64 + ap) * 512 + ct * 128) * 128;
  const u16* F2 = (const u16*)(p.ws + OFF_FM2);
  const u16* PX = (const u16*)(p.ws + OFF_PX);
  u16* MX = (u16*)(p.ws + OFF_H);
  bf16x8 yf[4][4];
#pragma unroll
  for (int jj = 0; jj < 4; ++jj)
#pragma unroll
    for (int ks = 0; ks < 4; ++ks) yf[jj][ks] = *(const bf16x8*)(F2 + (16 * jj + lr) * 128 + ks * 32 + lg * 8);
#pragma unroll
  for (int mi = 0; mi < 2; ++mi) {
    bf16x8 xf[4];
#pragma unroll
    for (int ks = 0; ks < 4; ++ks) xf[ks] = *(const bf16x8*)(T + (wave * 32 + mi * 16 + lr) * 128 + ks * 32 + lg * 8);
#pragma unroll
    for (int jj = 0; jj < 4; ++jj) {
      f32x4 acc = f32x4{0.f, 0.f, 0.f, 0.f};
#pragma unroll
      for (int ks = 0; ks < 4; ++ks) acc = mfma16(xf[ks], yf[jj][ks], acc);
      int bp = 16 * jj + lr;
      long m = (long)b * TPB + 256 + ap + 64 * bp;
      int col = ct * 128 + wave * 32 + mi * 16 + 4 * lg;
      u32x2 gg = *(const u32x2*)(PX + m * 2048 + 1536 + col);
      float g0 = bf2f(gg.x & 0xffff), g1 = bf2f(gg.x >> 16), g2 = bf2f(gg.y & 0xffff), g3 = bf2f(gg.y >> 16);
      const float scale = 1.f / 512.f;
      u32x2 ov = {pack2(acc[0] * scale * silu_f(g0), acc[1] * scale * silu_f(g1)),
                  pack2(acc[2] * scale * silu_f(g2), acc[3] * scale * silu_f(g3))};
      *(u32x2*)(MX + blk(m, 512 + col, 16)) = ov;
    }
  }
}

__device__ __forceinline__ void phase_mix_odd(const Params& p, int l, char* smem) {
  const bool need_ctx = l < 3;
  const int N_F1 = 4096, N_NA = 64 * (64 / NQR), N_CA = need_ctx ? 64 * (4 / NQR) : 0, N_FC = need_ctx ? 16 : 0;
  for (int rep = 0; rep < ((PROBE_DUP & 512) ? 2 : 1); ++rep)
  for (int it = VBLK; it < N_NA + N_CA; it += VGRID) {
    int id = it;
    bool win = id < N_NA;
    int b, h, r;
    if (win) { int bh = id / (64 / NQR); b = bh >> 3; h = bh & 7; r = id % (64 / NQR); }
    else { id -= N_NA; int bh = id / (4 / NQR); b = bh >> 3; h = bh & 7; r = id % (4 / NQR); }
    na_item(p, l, b, h, r, win, smem + VHALF * 65536);
  }
  for (int rep = 0; rep < ((PROBE_DUP & 256) ? 2 : 1); ++rep)
  for (int it = VBLK; it < N_F1 / 2; it += VGRID) fft_stage1_item(p, it >> 8, it & 255);
  for (int it = blockIdx.x; it < N_FC; it += gridDim.x) {
    fourier_ctx_tile(p, it >> 1, it & 1, smem);
  }
}
__device__ __forceinline__ void phase_mix_odd_b(const Params& p) {
  for (int rep = 0; rep < ((PROBE_DUP & 1024) ? 2 : 1); ++rep)
  for (int it = VBLK; it < 2048; it += VGRID) fft_stage2_item(p, it >> 8, (it >> 2) & 63, it & 3);
}

template <int NJ>
__device__ __forceinline__ void out_tile(const Params& p, int l, long row0, int nt, char* smem) {
  const int t = threadIdx.x, lane = t & 63, wave = t >> 6;
  const int wr = wave >> 2, wc = wave & 3, lr = lane & 15, lg = lane >> 4;
  const u16* MX = (const u16*)(p.ws + OFF_H);
  const u16* Wt = (const u16*)(p.ws + OFF_WT_OUT) + (long)l * 1024 * 1024;
  u16* Y = (u16*)(p.ws + OFF_PX);
  float* SSQ = (float*)(p.ws + OFF_SSQ);
  f32x4 acc[8][NJ];
  gemm_core<NJ>(Wt, (long)nt * 256, MX, row0, 1024, acc, smem);
#pragma unroll
  for (int jj = 0; jj < NJ; ++jj) {
    long m = row0 + wc * (16 * NJ) + jj * 16 + lr;
    float ss = 0.f;
#pragma unroll
    for (int i = 0; i < 8; ++i) {
      f32x4 v = acc[i][jj];
      ss += v[0] * v[0] + v[1] * v[1] + v[2] * v[2] + v[3] * v[3];
      u32x2 o = {pack2(v[0], v[1]), pack2(v[2], v[3])};
      *(u32x2*)(Y + m * 1024 + nt * 256 + wr * 128 + i * 16 + 4 * lg) = o;
    }
    ss += __shfl_xor(ss, 16);
    ss += __shfl_xor(ss, 32);
    if (lg == 0) SSQ[m * 16 + nt * 2 + wr] = ss;
  }
}
__device__ __forceinline__ void phase_out(const Params& p, int l, char* smem) {
  for (int it = blockIdx.x; it < 1024; it += gridDim.x) {
    int lt = it >> 2, nt = it & 3;
    int b = lt >> 5, j = lt & 31;
    out_tile<2>(p, l, (long)(b * 34 + 2 + j) * 128, nt, smem);
  }
  if (l < 3) {
    for (int id = blockIdx.x; id < 128; id += gridDim.x) {
      int nt = id & 3, h64 = (id >> 2) & 1, cm = id >> 3;
      int b = cm >> 1;
      out_tile<1>(p, l, (long)(b * 34 + (cm & 1)) * 128 + h64 * 64, nt, smem);
    }
  }
}

#define XB_TMO      128
#define XB_XCNT(j)  (256  + 64 * (j))
#define XB_XSUB(j)  (1280 + 64 * (j))
#define XB_XGEN(j)  (2304 + 64 * (j))
#define XB_TOP      3328
#define XB_TOPGEN   3392
#define XB_PERWG    3456
#define XB_SPIN_CAP (1u << 20)
__device__ __forceinline__ unsigned xb_ld(unsigned* p)              { return __hip_atomic_load(p, __ATOMIC_RELAXED, __HIP_MEMORY_SCOPE_AGENT); }
__device__ __forceinline__ unsigned xb_add(unsigned* p, unsigned v) { return __hip_atomic_fetch_add(p, v, __ATOMIC_RELAXED, __HIP_MEMORY_SCOPE_AGENT); }
__device__ __forceinline__ unsigned xb_xcc_id() { return (unsigned)__builtin_amdgcn_s_getreg((3 << 11) | 20) & 0xFu; }
#define XB_SPIN(cond, bar) do { unsigned _sp = 0; while (cond) { __builtin_amdgcn_s_sleep(1); \
    if ((++_sp & 255u) == 0u) { if (xb_ld(&(bar)[XB_TMO])) break; if (_sp > XB_SPIN_CAP) { atomicAdd(&(bar)[XB_TMO], 1u); break; } } } } while (0)
__device__ __forceinline__ void xcd_barrier_post(unsigned* bar) {
  if (threadIdx.x == 0) (void)xb_add(&bar[XB_XCNT(xb_xcc_id())], 1u);
}
__device__ __forceinline__ void xcd_barrier_complete(unsigned* bar, unsigned x, unsigned& nloc, unsigned& nx) {
  const unsigned G = gridDim.x;
  unsigned sum, cnt, mine, sp = 0u;
  for (;;) {
    sum = 0u; cnt = 0u; mine = 0u;
#pragma unroll
    for (unsigned j = 0; j < 16; ++j) { const unsigned c = xb_ld(&bar[XB_XCNT(j)]); sum += c; cnt += (c > 0u) ? 1u : 0u; mine = (j == x) ? c : mine; }
    if (sum == G) break;
    __builtin_amdgcn_s_sleep(1);
    if ((++sp & 255u) == 0u) { if (xb_ld(&bar[XB_TMO])) break; if (sp > XB_SPIN_CAP) { atomicAdd(&bar[XB_TMO], 1u); break; } }
  }
  nloc = mine > 0u ? mine : 1u; nx = cnt > 0u ? cnt : 1u;
}
__device__ __forceinline__ void xcd_barrier(unsigned* bar) {
  asm volatile("s_waitcnt vmcnt(0)" ::: "memory");
  __syncthreads();
  if (threadIdx.x == 0) {
    __builtin_amdgcn_s_waitcnt(0);
    const unsigned x = xb_xcc_id();
    unsigned* mine = bar + XB_PERWG + 2 * blockIdx.x;
    unsigned nloc = mine[0], nx = mine[1];
    if (nloc == 0u) { xcd_barrier_complete(bar, x, nloc, nx); mine[0] = nloc; mine[1] = nx; }
    const unsigned old = xb_add(&bar[XB_XSUB(x)], 1u);
    const unsigned gen = old / nloc;
    if (old + 1u == (gen + 1u) * nloc) {
      __builtin_amdgcn_fence(__ATOMIC_RELEASE, "agent");
      asm volatile("s_waitcnt vmcnt(0)" ::: "memory");
      const unsigned og = xb_add(&bar[XB_TOP], 1u);
      const unsigned tg = og / nx;
      if (og + 1u == (tg + 1u) * nx) xb_add(&bar[XB_TOPGEN], 1u);
      else XB_SPIN(xb_ld(&bar[XB_TOPGEN]) == tg, bar);
      __builtin_amdgcn_fence(__ATOMIC_ACQUIRE, "agent");
      xb_add(&bar[XB_XGEN(x)], 1u);
      asm volatile("s_waitcnt vmcnt(0)" ::: "memory");
    } else {
      XB_SPIN(xb_ld(&bar[XB_XGEN(x)]) == gen, bar);
      __builtin_amdgcn_fence(__ATOMIC_ACQUIRE, "agent");
      asm volatile("s_waitcnt vmcnt(0)" ::: "memory");
    }
  }
  __syncthreads();
}

#define GSYNC(PH) do { xcd_barrier(bar); } while (0)
#define RUN_PHASE(PH, CALL) if (PH >= ph_lo && PH < ph_hi) { if (PH > ph_lo) GSYNC(PH); CALL; }
#define RUN_PHASE_N(PH, L) if (PROBE_DUP & 2048) { GSYNC(PH); phase_proj<true>(p, L, smem); }
#define RUN_PHASE_D(BIT, PH, CALL) if (PH >= ph_lo && PH < ph_hi) { if (PH > ph_lo) GSYNC(PH); CALL; if (PROBE_DUP & (BIT)) { GSYNC(PH); CALL; } }
__global__ void __launch_bounds__(512, 2) mega(Params p, int ph_lo, int ph_hi) {
  extern __shared__ __attribute__((aligned(16))) char smem[];
  cg::grid_group grid = cg::this_grid();
  char* smh = smem + VHALF * 65536;
  unsigned* bar = (unsigned*)(p.ws + OFF_BAR);
  if (ph_lo < 0) grid.sync();
  xcd_barrier_post(bar);
  RUN_PHASE_D(16, 0, phase_prep(p, smh));
  RUN_PHASE_D(32, 1, phase_rows(p, -1));
  RUN_PHASE_D(1, 2, phase_proj(p, 0, smem));
  RUN_PHASE_N(2, 0);
  RUN_PHASE_D(2, 3, phase_mix_even(p, 0, smh));
  RUN_PHASE_D(8, 4, phase_out(p, 0, smem));
  RUN_PHASE(5, phase_rows(p, 0));
  RUN_PHASE_D(1, 6, phase_proj(p, 1, smem));
  RUN_PHASE_N(6, 1);
  RUN_PHASE_D(4, 7, phase_mix_odd(p, 1, smem));
  RUN_PHASE_D(4, 8, phase_mix_odd_b(p));
  RUN_PHASE_D(8, 9, phase_out(p, 1, smem));
  RUN_PHASE(10, phase_rows(p, 1));
  RUN_PHASE_D(1, 11, phase_proj(p, 2, smem));
  RUN_PHASE_N(11, 2);
  RUN_PHASE_D(2, 12, phase_mix_even(p, 2, smh));
  RUN_PHASE_D(8, 13, phase_out(p, 2, smem));
  RUN_PHASE(14, phase_rows(p, 2));
  RUN_PHASE_D(1, 15, phase_proj(p, 3, smem));
  RUN_PHASE_N(15, 3);
  RUN_PHASE_D(4, 16, phase_mix_odd(p, 3, smem));
  RUN_PHASE_D(4, 17, phase_mix_odd_b(p));
  RUN_PHASE_D(8, 18, phase_out(p, 3, smem));
  RUN_PHASE(19, phase_rows(p, 3));
}

extern "C" void kernel_launch(void* const* d_in, const int* in_sizes, int n_in, void* d_out, int out_size,
                              void* d_ws, size_t ws_size, hipStream_t stream) {
  static int grid_blocks = 0;
  if (!grid_blocks) {
    int dev = 0, cus = 0, per_cu = 0;
    hipGetDevice(&dev);
    hipDeviceGetAttribute(&cus, hipDeviceAttributeMultiprocessorCount, dev);
    hipFuncSetAttribute((const void*)mega, hipFuncAttributeMaxDynamicSharedMemorySize, SMEM_BYTES);
    hipOccupancyMaxActiveBlocksPerMultiprocessor(&per_cu, mega, 512, SMEM_BYTES);
    if (per_cu < 1) per_cu = 1;
    if (per_cu > 1) per_cu = 1;
    grid_blocks = cus * per_cu;
  }
  Params p{};
  p.x = (const float*)d_in[0]; p.c = (const float*)d_in[1]; p.ctx = (const float*)d_in[2]; p.c_ctx = (const float*)d_in[3];
  p.w_mod = (const float*)d_in[4]; p.b_mod = (const float*)d_in[5]; p.norm_pre = (const float*)d_in[6];
  p.norm_post = (const float*)d_in[7]; p.w_in_even = (const float*)d_in[8]; p.lam_a = (const float*)d_in[9];
  p.subln_a = (const float*)d_in[10]; p.conv_b = (const float*)d_in[11]; p.w_in_odd = (const float*)d_in[12];
  p.rpb_c = (const float*)d_in[13]; p.w_out = (const float*)d_in[14];
  p.out = (float*)d_out;
  p.ws = (char*)d_ws;
  if (ws_size < WS_TOTAL) fprintf(stderr, "workspace too small: %zu < %zu\n", ws_size, (size_t)WS_TOTAL);
#if MULTI_LAUNCH
  for (int ph = 0; ph < NPHASE; ++ph) {
    hipLaunchKernelGGL(mega, dim3(grid_blocks), dim3(512), SMEM_BYTES, stream, p, ph, ph + 1);
  }
#else
  int lo = 0, hi = NPHASE;
  void* args[] = {&p, &lo, &hi};
  hipMemsetAsync((char*)d_ws + OFF_BAR, 0, BAR_BYTES, stream);
  hipError_t e = hipLaunchCooperativeKernel((void*)mega, dim3(grid_blocks), dim3(512), args, SMEM_BYTES, stream);
  if (e != hipSuccess) fprintf(stderr, "cooperative launch failed: %s (grid %d)\n", hipGetErrorString(e), grid_blocks);
#endif
}
```

```cpp
#include <hip/hip_runtime.h>
#include <hip/hip_cooperative_groups.h>
#include <cstdio>
#include <cstdint>
namespace cg = cooperative_groups;

#ifndef PROBE_DUP
#define PROBE_DUP 0
#endif
#ifndef MULTI_LAUNCH
#define MULTI_LAUNCH 0
#endif

#define VTID  ((int)(threadIdx.x & 255))
#define VHALF ((int)(threadIdx.x >> 8))
#define VBLK  ((int)(blockIdx.x * 2 + (threadIdx.x >> 8)))
#define VGRID ((int)(gridDim.x * 2))
typedef unsigned short u16;
typedef unsigned __attribute__((ext_vector_type(4))) u32x4;
typedef unsigned __attribute__((ext_vector_type(2))) u32x2;
typedef float __attribute__((ext_vector_type(2))) f32x2;
typedef __attribute__((ext_vector_type(8))) short bf16x8;
typedef __attribute__((ext_vector_type(4))) float f32x4;
typedef __attribute__((ext_vector_type(2))) __bf16 bf2_t;
typedef __attribute__((ext_vector_type(2))) float f2_t;

#define TPB 4352
#define MTOT 34816
#define NPHASE 20
#define LOG2E 1.4426950408889634f
#define EPS 1e-6f

constexpr size_t OFF_WT_EVEN = 0;
constexpr size_t OFF_WT_ODD  = OFF_WT_EVEN + 2ull*4096*1024*2;
constexpr size_t OFF_WT_OUT  = OFF_WT_ODD + 2ull*3584*1024*2;
constexpr size_t OFF_MOD     = OFF_WT_OUT + 4ull*1024*1024*2;
constexpr size_t OFF_ROPE    = OFF_MOD + 4ull*9*3072*4;
constexpr size_t OFF_LAM     = OFF_ROPE + 4096;
constexpr size_t OFF_FM1     = OFF_LAM + 256;
constexpr size_t OFF_FM2     = OFF_FM1 + 128*128*2;
constexpr size_t OFF_TWC     = OFF_FM2 + 64*128*2;
constexpr size_t OFF_TWS     = OFF_TWC + 64*64*4;
constexpr size_t OFF_TG      = OFF_TWS + 64*64*4;
constexpr size_t OFF_DFTC    = OFF_TG + 8ull*64*512*128*2;
constexpr size_t OFF_H       = OFF_DFTC + 256ull*512*2;
constexpr size_t OFF_PX      = OFF_H + (size_t)MTOT*1024*2;
constexpr size_t OFF_ZT      = OFF_PX + (size_t)MTOT*2048*2;
constexpr size_t OFF_ZTC     = OFF_ZT + 8ull*512*8192*2;
constexpr size_t OFF_VT      = OFF_PX + (size_t)MTOT*3584*2;
constexpr size_t OFF_CS      = OFF_VT + 8ull*8*64*4352*2;
constexpr size_t OFF_SSQ     = OFF_CS + 2048ull*1024*4;
constexpr size_t OFF_BAR     = OFF_SSQ + (size_t)MTOT*16*4;
constexpr size_t BAR_BYTES   = 32768;
constexpr int SMEM_BYTES = 131072;
constexpr size_t OFF_BT      = OFF_BAR + BAR_BYTES;
constexpr size_t OFF_KMAX    = OFF_BT + 2ull*8*15*4096*4;
constexpr size_t WS_TOTAL    = OFF_KMAX + 1024;

struct Params {
  const float *x, *c, *ctx, *c_ctx, *w_mod, *b_mod, *norm_pre, *norm_post, *w_in_even, *lam_a,
              *subln_a, *conv_b, *w_in_odd, *rpb_c, *w_out;
  float* out;
  char* ws;
};

__device__ __forceinline__ float silu_f(float x) { return x / (1.f + __expf(-x)); }
__device__ __forceinline__ float bf2f(u16 v) { return __uint_as_float(((unsigned)v) << 16); }
__device__ __forceinline__ unsigned pack2(float a, float b) {
  f2_t v = {a, b};
  bf2_t r = __builtin_convertvector(v, bf2_t);
  return *(unsigned*)&r;
}
__device__ __forceinline__ u16 f2bf(float a) { return (u16)(pack2(a, 0.f) & 0xffff); }
__device__ __forceinline__ long blk(long row, int k, int KS) {
  return ((row >> 7) * KS + (k >> 6)) * 8192 + (row & 127) * 64 + (k & 63);
}
__device__ __forceinline__ int swz(int r, int c) { return r * 128 + ((c ^ ((r >> 1) & 7)) << 4); }
__device__ __forceinline__ f32x4 mfma16(bf16x8 a, bf16x8 b, f32x4 c) {
  return __builtin_amdgcn_mfma_f32_16x16x32_bf16(a, b, c, 0, 0, 0);
}
__device__ __forceinline__ float fexp2(float x) { return __builtin_amdgcn_exp2f(x); }

#define WAIT_V(n) asm volatile("s_waitcnt vmcnt(%0)" ::"n"(n) : "memory")
#define RAW_BARRIER() do { asm volatile("s_waitcnt lgkmcnt(0)" ::: "memory"); __builtin_amdgcn_s_barrier(); } while (0)
template <int NJ>
__device__ __forceinline__ void gemm_core(const u16* A, long rowA0, const u16* B, long rowB0, int K,
                                          f32x4 (&acc)[8][NJ], char* smem, int permA = -1) {
  const int t = threadIdx.x, lane = t & 63, wave = t >> 6;
  const int wr = wave >> 2, wc = wave & 3;
  const int lr = lane & 15, lg = lane >> 4;
  const int KS = K >> 6;
  constexpr int NBQ = NJ;
#pragma unroll
  for (int i = 0; i < 8; ++i)
#pragma unroll
    for (int j = 0; j < NJ; ++j) acc[i][j] = f32x4{0.f, 0.f, 0.f, 0.f};
  const u16* ap[4];
  const u16* bp[NBQ];
#pragma unroll
  for (int q = 0; q < 4; ++q) {
    int R = (q * 8 + wave) * 8 + (lane >> 3);
    int cl = (lane & 7) ^ ((R >> 1) & 7);
    long rowA = permA < 0 ? rowA0 + R : rowA0 + 64 * (R & 63) + 4 * permA + (R >> 6);
    ap[q] = A + blk(rowA, 0, KS) + cl * 8;
  }
#pragma unroll
  for (int q = 0; q < NBQ; ++q) {
    int R = (q * 8 + wave) * 8 + (lane >> 3);
    int cl = (lane & 7) ^ ((R >> 1) & 7);
    bp[q] = B + blk(rowB0 + R, 0, KS) + cl * 8;
  }
  const int fb0 = lr * 128 + ((lg ^ ((lr >> 1) & 7)) << 4);
  char* sw = smem + wave * 1024;
#define GEMM_ISSUE1(kt, pc) do { const int s_ = ((kt) & 1) * 65536; const long ko_ = (long)(kt) * 8192; \
    if ((pc) < 4) __builtin_amdgcn_global_load_lds((const unsigned*)(ap[(pc) & 3] + ko_), (unsigned*)(sw + s_ + ((pc) & 3) * 8192), 16, 0, 0); \
    else __builtin_amdgcn_global_load_lds((const unsigned*)(bp[((pc) - 4) % NBQ] + ko_), (unsigned*)(sw + s_ + 32768 + (((pc) - 4) % NBQ) * 8192), 16, 0, 0); } while (0)
  __syncthreads();
#pragma unroll
  for (int pc = 0; pc < 4 + NBQ; ++pc) GEMM_ISSUE1(0, pc);
#pragma unroll 1
  for (int kt = 0; kt < KS; ++kt) {
    WAIT_V(0);
    RAW_BARRIER();
    const bool more = kt + 1 < KS;
    const char* sa = smem + (kt & 1) * 65536;
    const char* sb = sa + 32768;
#pragma unroll
    for (int ks = 0; ks < 2; ++ks) {
      bf16x8 bfr[NJ];
#pragma unroll
      for (int j = 0; j < NJ; ++j) bfr[j] = *(const bf16x8*)(sb + wc * (NJ * 2048) + j * 2048 + (fb0 ^ (ks << 6)));
#pragma unroll
      for (int i = 0; i < 8; ++i) {
        bf16x8 af = *(const bf16x8*)(sa + wr * 16384 + i * 2048 + (fb0 ^ (ks << 6)));
        if (ks == 0 && i < 4 + NBQ) {
          __builtin_amdgcn_sched_barrier(0);
          if (more) GEMM_ISSUE1(kt + 1, i);
          __builtin_amdgcn_sched_barrier(0);
        }
#pragma unroll
        for (int j = 0; j < NJ; ++j) acc[i][j] = mfma16(af, bfr[j], acc[i][j]);
      }
    }
  }
#undef GEMM_ISSUE1

}

__device__ __forceinline__ void wtrans_tile(const float* W, int ldw, int k0, int n0src, u16* Wt, int n0dst, char* smem) {
  float(*tile)[65] = (float(*)[65])smem;
  const int t = VTID;
  __syncthreads();
#pragma unroll
  for (int i = 0; i < 16; ++i) {
    int kk = (t >> 6) + 4 * i, nn = t & 63;
    tile[kk][nn] = W[(long)(k0 + kk) * ldw + n0src + nn];
  }
  __syncthreads();
#pragma unroll
  for (int i = 0; i < 16; ++i) {
    int nn = (t >> 6) + 4 * i, kk = t & 63;
    Wt[blk(n0dst + nn, k0 + kk, 16)] = f2bf(tile[kk][nn]);
  }
}

__device__ __forceinline__ void phase_prep(const Params& p, char* smem) {
  const int t = VTID;
  u16* wt_even = (u16*)(p.ws + OFF_WT_EVEN);
  u16* wt_odd = (u16*)(p.ws + OFF_WT_ODD);
  u16* wt_out = (u16*)(p.ws + OFF_WT_OUT);
  float* modv = (float*)(p.ws + OFF_MOD);
  const int N_EVEN = 2048, N_ODDP = 1280, N_OUT = 1024, N_FOLD = 256, N_MOD = 384, N_BT = 240, N_DFT = 3, N_ROPE = 1;
  const int total = N_EVEN + N_ODDP + N_OUT + N_FOLD + N_MOD + N_BT + N_DFT + N_ROPE;
  for (int it = VBLK; it < total; it += VGRID) {
    int id = it;
    if (id < N_MOD) {
      int l = id / 96, jb = id % 96;
      float* sc = (float*)smem;
      float* red = (float*)(smem + 36864);
      __syncthreads();
      for (int idx = t; idx < 9 * 1024; idx += 256) {
        int r = idx >> 10, k = idx & 1023;
        float v = r < 8 ? p.c[r * 1024 + k] : p.c_ctx[k];
        sc[idx] = silu_f(v);
      }
      __syncthreads();
      int col = jb * 32 + (t & 31), kp = t >> 5;
      float a0 = 0, a1 = 0, a2 = 0, a3 = 0, a4 = 0, a5 = 0, a6 = 0, a7 = 0, a8 = 0;
      const float* wp = p.w_mod + ((long)l * 1024 + kp * 128) * 3072 + col;
      const float* sp = sc + kp * 128;
#pragma unroll 8
      for (int k = 0; k < 128; ++k) {
        float w = wp[(long)k * 3072];
        a0 += sp[k] * w; a1 += sp[1024 + k] * w; a2 += sp[2048 + k] * w; a3 += sp[3072 + k] * w;
        a4 += sp[4096 + k] * w; a5 += sp[5120 + k] * w; a6 += sp[6144 + k] * w; a7 += sp[7168 + k] * w;
        a8 += sp[8192 + k] * w;
      }
      float* rp = red + kp * 288 + (t & 31);
      rp[0] = a0; rp[32] = a1; rp[64] = a2; rp[96] = a3; rp[128] = a4; rp[160] = a5; rp[192] = a6; rp[224] = a7; rp[256] = a8;
      __syncthreads();
      for (int idx = t; idx < 288; idx += 256) {
        int r = idx >> 5, cc = idx & 31;
        float s = p.b_mod[l * 3072 + jb * 32 + cc];
#pragma unroll
        for (int q = 0; q < 8; ++q) s += red[q * 288 + r * 32 + cc];
        modv[(l * 9 + r) * 3072 + jb * 32 + cc] = s;
      }
      continue;
    }
    id -= N_MOD;
    if (id < N_EVEN) {
      int j = id >> 10, r = id & 1023, kt = r >> 6, nt = r & 63;
      wtrans_tile(p.w_in_even + (long)j * 1024 * 4096, 4096, kt * 64, nt * 64, wt_even + (long)j * 4096 * 1024, nt * 64, smem);
      continue;
    }
    id -= N_EVEN;
    if (id < N_ODDP) {
      int j = id / 640, r = id % 640, kt = r / 40, q = r % 40;
      int sec = q >> 3, nt = q & 7;
      int ssec = sec < 4 ? sec : 5;
      wtrans_tile(p.w_in_odd + (long)j * 1024 * 3072, 3072, kt * 64, ssec * 512 + nt * 64,
                  wt_odd + (long)j * 3584 * 1024, ssec * 512 + nt * 64, smem);
      continue;
    }
    id -= N_ODDP;
    if (id < N_OUT) {
      int l = id >> 8, r = id & 255, kt = r >> 4, nt = r & 15;
      wtrans_tile(p.w_out + (long)l * 1024 * 1024, 1024, kt * 64, nt * 64, wt_out + (long)l * 1024 * 1024, nt * 64, smem);
      continue;
    }
    id -= N_OUT;
    if (id < N_FOLD) {
      int j = id >> 7, r = id & 127, g = r >> 4, kb = r & 15;
      float(*u)[65] = (float(*)[65])smem;
      float* cosT = (float*)(smem + 64 * 65 * 4);
      float* sinT = cosT + 64;
      __syncthreads();
      const float* W = p.w_in_odd + (long)j * 1024 * 3072;
#pragma unroll
      for (int i = 0; i < 16; ++i) {
        int kk = (t >> 6) + 4 * i, cc = t & 63;
        u[kk][cc] = W[(long)(kb * 64 + kk) * 3072 + 2048 + g * 64 + cc];
      }
      if (t < 64) {
        float s, c;
        sincospif((float)t / 32.f, &s, &c);
        cosT[t] = c; sinT[t] = s;
      }
      __syncthreads();
      int kk = t & 63, cq = t >> 6;
      u16* dst = wt_odd + (long)j * 3584 * 1024;
      for (int c2 = cq * 16; c2 < cq * 16 + 16; ++c2) {
        float sr = 0.f, si = 0.f;
#pragma unroll 8
        for (int cc = 0; cc < 64; ++cc) {
          int idx = (cc * c2) & 63;
          float v = u[kk][cc];
          sr += v * cosT[idx];
          si -= v * sinT[idx];
        }
        dst[blk(4 * 512 + g * 64 + c2, kb * 64 + kk, 16)] = f2bf(sr);
        dst[blk(6 * 512 + g * 64 + c2, kb * 64 + kk, 16)] = f2bf(si);
      }
      continue;
    }
    id -= N_FOLD;
    if (id < N_BT) {
      int jh = id / 15, roff = id % 15;
      const float* src = p.rpb_c + (long)jh * 15 * 31 + roff * 31;
      float* dst = (float*)(p.ws + OFF_BT) + ((long)id * 256 + t) * 16;
      int w = t >> 6, lane = t & 63, lr = lane & 15, lg = lane >> 4;
      int qc = 16 * w + lr, cs = min(max(qc - 8, 0), 48);
#pragma unroll
      for (int k4 = 0; k4 < 4; ++k4) {
        f32x4 v;
#pragma unroll
        for (int e = 0; e < 4; ++e) {
          int kc = k4 * 16 + 4 * lg + e;
          bool valid = (kc >= cs) && (kc < cs + 16);
          v[e] = valid ? src[min(max(kc - qc + 15, 0), 30)] * LOG2E : -1e30f;
        }
        *(f32x4*)(dst + k4 * 4) = v;
      }
      continue;
    }
    id -= N_BT;
    if (id < N_DFT) {
      float* ct = (float*)smem;
      float* st = ct + 256;
      __syncthreads();
      if (id < 1) {
        u16* F1 = (u16*)(p.ws + OFF_FM1);
        u16* F2 = (u16*)(p.ws + OFF_FM2);
        float* TC = (float*)(p.ws + OFF_TWC);
        float* TS = (float*)(p.ws + OFF_TWS);
        if (t < 64) { float sn, cs; sincospif((float)t / 32.f, &sn, &cs); ct[t] = cs; st[t] = sn; }
        __syncthreads();
        for (int idx = t; idx < 128 * 128; idx += 256) {
          int row = idx >> 7, k = idx & 127;
          int rp = row >> 6, ap = row & 63, ri = k >> 6, a = k & 63;
          float cs = ct[(a * ap) & 63], sn = st[(a * ap) & 63];
          float v = (rp == 0) ? (ri == 0 ? cs : sn) : (ri == 0 ? -sn : cs);
          F1[idx] = f2bf(v);
        }
        for (int idx = t; idx < 64 * 128; idx += 256) {
          int bp = idx >> 7, k = idx & 127, ri = k >> 6, bb = k & 63;
          F2[idx] = f2bf(ri == 0 ? ct[(bb * bp) & 63] : st[(bb * bp) & 63]);
        }
        for (int idx = t; idx < 64 * 64; idx += 256) {
          int ap = idx >> 6, bb = idx & 63;
          float sn, cs;
          sincospif((float)(ap * bb) / 2048.f, &sn, &cs);
          TC[idx] = cs; TS[idx] = sn;
        }
      } else {
        u16* D = (u16*)(p.ws + OFF_DFTC);
        { float sn, cs; sincospif((float)t / 128.f, &sn, &cs); ct[t] = cs; st[t] = sn; }
        __syncthreads();
        for (int q = 0; q < 32; ++q) {
          int chunk = (id - 1) * 8192 + q * 256 + t;
          int row = chunk >> 6, col0 = (chunk & 63) * 8;
          int ri = col0 >> 8, n0 = col0 & 255;
          float v[8];
#pragma unroll
          for (int e = 0; e < 8; ++e) {
            int idx = (row * (n0 + e)) & 255;
            v[e] = ri ? st[idx] : ct[idx];
          }
          u32x4 o = {pack2(v[0], v[1]), pack2(v[2], v[3]), pack2(v[4], v[5]), pack2(v[6], v[7])};
          *(u32x4*)(D + blk(row, col0, 8)) = o;
        }
      }
      continue;
    }
    id -= N_DFT;
    {
      __syncthreads();
      __syncthreads();
      f32x2* tab = (f32x2*)(p.ws + OFF_ROPE);
      for (int i = t; i < 512; i += 256) {
        int pos = i >> 3, fi = i & 7;
        float inv = exp2f(-(float)fi * (13.287712379549449f / 8.f));
        float ang = (float)pos * inv;
        float s, c;
        sincospif(ang * 0.3183098861837907f, &s, &c);
        tab[i] = f32x2{c, s};
      }
      ((unsigned*)(p.ws + OFF_KMAX))[t] = 0u;
      if (t < 2) {
        const float* lp = p.lam_a + t * 128;
        float s1 = 0.f, s2 = 0.f;
#pragma unroll 1
        for (int i = 0; i < 32; ++i) { s1 += lp[i] * lp[32 + i]; s2 += lp[64 + i] * lp[96 + i]; }
        float lam_init = 0.8f - 0.6f * expf(-0.3f * (float)(2 * t));
        ((float*)(p.ws + OFF_LAM))[t] = expf(s1) - expf(s2) + lam_init;
      }
    }
  }
}

__device__ __forceinline__ void phase_rows(const Params& p, int l) {
  const int t = VTID, lane = t & 63, wave = t >> 6;
  const float* modv = (const float*)(p.ws + OFF_MOD);
  const u16* Y = (const u16*)(p.ws + OFF_PX);
  const float* SSQ = (const float*)(p.ws + OFF_SSQ);
  float* CS = (float*)(p.ws + OFF_CS);
  u16* H = (u16*)(p.ws + OFF_H);
  for (int it = VBLK; it < MTOT / 16; it += VGRID) {
    const int m0 = it * 16 + wave * 4;
    const int b = m0 / TPB, w0 = m0 - b * TPB;
    const bool isc = w0 < 256;
    if (l == 3 && isc) continue;
    const long srow0 = isc ? (long)(b * 256 + w0) : (long)(b * 4096 + w0 - 256);
    const float* xin0 = (l <= 0) ? ((isc ? p.ctx : p.x) + srow0 * 1024) : ((isc ? CS : p.out) + srow0 * 1024);
    float* xout0 = (isc ? CS : p.out) + srow0 * 1024;
    const int r = isc ? 8 : b;
    f32x4 xall[4][4];
    u32x2 yall[4][4];
    float ssall[4];
#pragma unroll
    for (int rr = 0; rr < 4; ++rr) {
#pragma unroll
      for (int i = 0; i < 4; ++i) xall[rr][i] = *(const f32x4*)(xin0 + rr * 1024 + lane * 4 + 256 * i);
      if (l >= 0) {
#pragma unroll
        for (int i = 0; i < 4; ++i) yall[rr][i] = *(const u32x2*)(Y + (long)(m0 + rr) * 1024 + lane * 4 + 256 * i);
        ssall[rr] = lane < 8 ? SSQ[(long)(m0 + rr) * 16 + lane] : 0.f;
      }
    }
#pragma unroll
    for (int rr = 0; rr < 4; ++rr) {
      const int m = m0 + rr;
      float* xout = xout0 + rr * 1024;
      f32x4 xv[4];
#pragma unroll
      for (int i = 0; i < 4; ++i) xv[i] = xall[rr][i];
      if (l >= 0) {
        float ss = ssall[rr];
#pragma unroll
        for (int o = 1; o < 64; o <<= 1) ss += __shfl_xor(ss, o);
        float rstd = rsqrtf(ss * (1.f / 1024.f) + EPS);
        const float* gp = modv + (l * 9 + r) * 3072 + 2048;
        const float* np = p.norm_post + l * 1024;
#pragma unroll
        for (int i = 0; i < 4; ++i) {
          int k = lane * 4 + 256 * i;
          u32x2 yb = yall[rr][i];
          f32x4 y = {bf2f(yb.x & 0xffff), bf2f(yb.x >> 16), bf2f(yb.y & 0xffff), bf2f(yb.y >> 16)};
          f32x4 g = *(const f32x4*)(gp + k);
          f32x4 n = *(const f32x4*)(np + k);
          xv[i].x += g.x * (y.x * rstd * n.x);
          xv[i].y += g.y * (y.y * rstd * n.y);
          xv[i].z += g.z * (y.z * rstd * n.z);
          xv[i].w += g.w * (y.w * rstd * n.w);
          *(f32x4*)(xout + k) = xv[i];
        }
      }
      if (l < 3) {
        int ln = l + 1;
        float ss = 0.f;
#pragma unroll
        for (int i = 0; i < 4; ++i) ss += xv[i].x * xv[i].x + xv[i].y * xv[i].y + xv[i].z * xv[i].z + xv[i].w * xv[i].w;
#pragma unroll
        for (int o = 1; o < 64; o <<= 1) ss += __shfl_xor(ss, o);
        float rstd = rsqrtf(ss * (1.f / 1024.f) + EPS);
        const float* mp = modv + (ln * 9 + r) * 3072;
        const float* np = p.norm_pre + ln * 1024;
#pragma unroll
        for (int i = 0; i < 4; ++i) {
          int k = lane * 4 + 256 * i;
          f32x4 sh = *(const f32x4*)(mp + k);
          f32x4 sc = *(const f32x4*)(mp + 1024 + k);
          f32x4 n = *(const f32x4*)(np + k);
          float h0 = xv[i].x * rstd * n.x * (1.f + sc.x) + sh.x;
          float h1 = xv[i].y * rstd * n.y * (1.f + sc.y) + sh.y;
          float h2 = xv[i].z * rstd * n.z * (1.f + sc.z) + sh.z;
          float h3 = xv[i].w * rstd * n.w * (1.f + sc.w) + sh.w;
          u32x2 o = {pack2(h0, h1), pack2(h2, h3)};
          *(u32x2*)(H + blk(m, k, 16)) = o;
        }
      }
    }
  }
}

template <bool NOSTORE = false>
__device__ __forceinline__ void phase_proj(const Params& p, int l, char* smem) {
  const int t = threadIdx.x, lane = t & 63, wave = t >> 6;
  const int wr = wave >> 2, wc = wave & 3, lr = lane & 15, lg = lane >> 4;
  const bool even = (l & 1) == 0;
  const int j = l >> 1;
  const u16* H = (const u16*)(p.ws + OFF_H);
  const u16* Wt = even ? (const u16*)(p.ws + OFF_WT_EVEN) + (long)j * 4096 * 1024
                       : (const u16*)(p.ws + OFF_WT_ODD) + (long)j * 3584 * 1024;
  u16* PX = (u16*)(p.ws + OFF_PX);
  u16* VT = (u16*)(p.ws + OFF_VT);
  u16* ZT = (u16*)(p.ws + OFF_ZT);
  u16* ZTC = (u16*)(p.ws + OFF_ZTC);
  const f32x2* rope = (const f32x2*)(p.ws + OFF_ROPE);
  const int pitch = even ? 3584 : 2048;
  const int NWN = even ? 14 : 8;
  const int NWT = even ? 2 : 6;
  const int n_normal = 136 * NWN, total = n_normal + 136 * NWT;
  for (int it = blockIdx.x; it < total; it += gridDim.x) {
    const bool trans = it >= n_normal;
    int b, sec, sc0, tw;
    if (!trans) {
      int tt = it % 136, wt = it / 136;
      b = tt / 17; tw = tt % 17;
      int sidx = wt >> 1;
      sec = even ? (sidx < 2 ? sidx : sidx + 1) : (sidx < 2 ? sidx : (sidx == 2 ? 3 : 5));
      sc0 = (wt & 1) * 256;
    } else {
      int it2 = it - n_normal;
      int tt = it2 / NWT, wt = it2 % NWT;
      b = tt / 17; tw = tt % 17;
      sec = even ? 2 : 2 + 2 * (wt >> 1);
      sc0 = (wt & 1) * 256;
    }
    const bool isc = tw == 0;
    if (l == 3 && isc && !(sec == 1 || sec == 2)) continue;
    f32x4 acc[8][4];
    const long rowW = (long)sec * 512 + sc0;
    const long rowH = (long)b * TPB + tw * 256;
    const bool zperm = trans && sec != 2 && !isc;
    gemm_core<4>(trans ? H : Wt, trans ? (zperm ? (long)(b * TPB + 256) : rowH) : rowW, trans ? Wt : H, trans ? rowW : rowH, 1024, acc, smem,
                 zperm ? tw - 1 : -1);
    if (NOSTORE) {
      float ss = 0.f;
#pragma unroll
      for (int i = 0; i < 8; ++i)
#pragma unroll
        for (int jj = 0; jj < 4; ++jj) ss += acc[i][jj][0] + acc[i][jj][1] + acc[i][jj][2] + acc[i][jj][3];
      if (ss == 12345.678f) PX[t] = 0;
      continue;
    }
    __syncthreads();
    char* wreg = smem + wave * 16384;
    const bool do_rope = !trans && even && sec < 2 && !isc;
#pragma unroll
    for (int jj = 0; jj < 4; ++jj)
#pragma unroll
      for (int i = 0; i < 8; ++i) {
        u32x2 o = {pack2(acc[i][jj][0], acc[i][jj][1]), pack2(acc[i][jj][2], acc[i][jj][3])};
        int c8 = i * 4 + lg;
        if (trans && sec == 2) c8 = (c8 & ~7) | ((c8 & 3) << 1) | ((c8 >> 2) & 1);
        *(u32x2*)(wreg + (jj * 16 + lr) * 256 + ((c8 ^ (lr << 1)) << 3)) = o;
      }
    __syncthreads();
    int pxcol;
    if (even) pxcol = sec < 2 ? sec * 512 : (sec - 1) * 512;
    else pxcol = sec == 0 ? 0 : sec == 1 ? 512 : sec == 3 ? 1024 : 1536;
    const bool knorm = !trans && even && sec == 1;
    float kmx = 0.f;
#pragma unroll 2
    for (int n = 0; n < 16; ++n) {
      int row = n * 4 + lg, k = lr;
      u32x4 v = *(const u32x4*)(wreg + row * 256 + ((k ^ (row & 15)) << 4));
      if (!trans) {
        long m = (long)b * TPB + tw * 256 + wc * 64 + row;
        if (do_rope) {
          u32x4 w = *(const u32x4*)(wreg + row * 256 + (((k ^ 1) ^ (row & 15)) << 4));
          int tl = tw * 256 - 256 + wc * 64 + row;
          int pos = ((k >> 1) & 1) ? (tl & 63) : (tl >> 6);
          const f32x4* rp = (const f32x4*)(rope + pos * 8);
          const float sg = (k & 1) ? 1.f : -1.f;
          u32x4 r;
#pragma unroll
          for (int e = 0; e < 4; ++e) {
            f32x4 cs = rp[e];
            float a0 = bf2f(v[e] & 0xffff), a1 = bf2f(v[e] >> 16), o0 = bf2f(w[e] & 0xffff), o1 = bf2f(w[e] >> 16);
            r[e] = pack2(a0 * cs[0] + sg * o0 * cs[1], a1 * cs[2] + sg * o1 * cs[3]);
          }
          v = r;
        }
        if (knorm) {
          float ssq = 0.f;
#pragma unroll
          for (int e = 0; e < 4; ++e) { float a0 = bf2f(v[e] & 0xffff), a1 = bf2f(v[e] >> 16); ssq += a0 * a0 + a1 * a1; }
          ssq += __shfl_xor(ssq, 1);
          ssq += __shfl_xor(ssq, 2);
          kmx = fmaxf(kmx, ssq);
        }
        *(u32x4*)(PX + m * pitch + pxcol + sc0 + wr * 128 + k * 8) = v;
      } else {
        int wcol = sc0 + wc * 64 + row;
        int tk = k * 8;
        if (sec == 2) {
          int h = wcol >> 6, d = wcol & 63;
          *(u32x4*)(VT + ((long)((b * 8 + h) * 64 + d)) * TPB + tw * 256 + wr * 128 + tk) = v;
        } else {
          int ri = sec == 6 ? 1 : 0;
          if (isc) *(u32x4*)(ZTC + blk(b * 512 + wcol, ri * 256 + wr * 128 + tk, 8)) = v;
          else     *(u32x4*)(ZT + ((long)((b * 512 + wcol) * 2 + ri)) * 4096 + (4 * (tw - 1) + wr * 2) * 64 + tk) = v;
        }
      }
    }
    if (knorm) {
      kmx = fmaxf(kmx, __shfl_xor(kmx, 16));
      kmx = fmaxf(kmx, __shfl_xor(kmx, 32));
      if (lg == 0 && (lr & 3) == 0) {
        int col = sc0 + wr * 128 + lr * 8;
        atomicMax((unsigned*)(p.ws + OFF_KMAX) + ((j * 8 + b) * 8 + (col >> 6)) * 2 + ((col >> 5) & 1), __float_as_uint(kmx));
      }
    }
  }
}

__device__ __forceinline__ void ld_tile64(const u16* base, long pitch, u32x4 (&r)[2]) {
  const int t = VTID, c = t & 7, r0 = t >> 3;
  r[0] = *(const u32x4*)(base + (long)r0 * pitch + c * 8);
  r[1] = *(const u32x4*)(base + (long)(r0 + 32) * pitch + c * 8);
}
__device__ __forceinline__ void st_tile64(char* s, const u32x4 (&r)[2]) {
  const int t = VTID, c = t & 7, r0 = t >> 3;
  *(u32x4*)(s + swz(r0, c)) = r[0];
  *(u32x4*)(s + swz(r0 + 32, c)) = r[1];
}
__device__ __forceinline__ bf16x8 ld_vfrag(const char* sV, int vb, int dt, int ks) {
  return *(const bf16x8*)(sV + dt * 2048 + (vb ^ (ks << 6)));
}

#define NQT 2
__device__ __forceinline__ void diff_attn_item(const Params& p, int l, int b, int h, int q0, int nkeys, char* smem) {
  const int t = VTID, lane = t & 63, wave = t >> 6, lr = lane & 15, lg = lane >> 4;
  const int j = l >> 1;
  const u16* PX = (const u16*)(p.ws + OFF_PX);
  const u16* VT = (const u16*)(p.ws + OFF_VT);
  u16* MX = (u16*)(p.ws + OFF_H);
  const int pitch = 3584;
  const float cexp = 0.17677669529663687f * LOG2E;
  const int kx = (lr >> 1) & 7;
  const int kb0 = lr * 128 + ((lg ^ kx) << 4);
  const int vb = kb0;
  int opq = 0;
  asm volatile("" : "+s"(opq));
  smem += opq;
  const float lam = ((const float*)(p.ws + OFF_LAM))[j + opq];
  const float one_m_li = 1.f - (0.8f - 0.6f * expf(-0.3f * (float)l));
  const long rowbase = (long)b * TPB;
  bf16x8 Q[2][NQT];
#pragma unroll
  for (int m = 0; m < 2; ++m)
#pragma unroll
    for (int qt = 0; qt < NQT; ++qt)
      Q[m][qt] = *(const bf16x8*)(PX + (rowbase + q0 + wave * (16 * NQT) + qt * 16 + lr) * pitch + h * 64 + m * 32 + lg * 8);
  f32x4 O[2][NQT][4], Ls[2][NQT];
  float Mx[2][NQT];
#pragma unroll
  for (int m = 0; m < 2; ++m) {
    const float kmax2 = __uint_as_float(((const unsigned*)(p.ws + OFF_KMAX))[((j * 8 + b) * 8 + h) * 2 + m + opq]);
#pragma unroll
    for (int qt = 0; qt < NQT; ++qt) {
      u32x4 qu = __builtin_bit_cast(u32x4, Q[m][qt]);
      float qs = 0.f;
#pragma unroll
      for (int e = 0; e < 4; ++e) { float a0 = bf2f(qu[e] & 0xffff), a1 = bf2f(qu[e] >> 16); qs += a0 * a0 + a1 * a1; }
      qs += __shfl_xor(qs, 16);
      qs += __shfl_xor(qs, 32);
      Mx[m][qt] = sqrtf(qs * kmax2) * (cexp * 1.001f) + 1e-3f - 32.f;
      Ls[m][qt] = f32x4{0.f, 0.f, 0.f, 0.f};
#pragma unroll
      for (int dt = 0; dt < 4; ++dt) O[m][qt][dt] = f32x4{0.f, 0.f, 0.f, 0.f};
    }
  }
  const u32x4 ones_u = {0x3F803F80u, 0x3F803F80u, 0x3F803F80u, 0x3F803F80u};
  const bf16x8 ones = __builtin_bit_cast(bf16x8, ones_u);
  const u16* kbase = PX + rowbase * pitch + 512 + h * 64;
  const u16* vbase = VT + (long)((b * 8 + h) * 64) * TPB;
  const u16* kp[2];
  const u16* vp[2];
#pragma unroll
  for (int q = 0; q < 2; ++q) {
    int R = (q * 4 + wave) * 8 + (lane >> 3);
    int cl = (lane & 7) ^ ((R >> 1) & 7);
    kp[q] = kbase + (long)R * pitch + cl * 8;
    vp[q] = vbase + (long)R * TPB + cl * 8;
  }
  char* sw = smem + wave * 1024;
#define ATT_ISSUE(kt) do { const int s_ = ((kt) & 3) * 16384; \
    __builtin_amdgcn_global_load_lds((const unsigned*)(kp[0] + (long)(kt) * 64 * pitch), (unsigned*)(sw + s_), 16, 0, 0); \
    __builtin_amdgcn_global_load_lds((const unsigned*)(kp[1] + (long)(kt) * 64 * pitch), (unsigned*)(sw + s_ + 4096), 16, 0, 0); \
    __builtin_amdgcn_global_load_lds((const unsigned*)(vp[0] + (kt) * 64), (unsigned*)(sw + s_ + 8192), 16, 0, 0); \
    __builtin_amdgcn_global_load_lds((const unsigned*)(vp[1] + (kt) * 64), (unsigned*)(sw + s_ + 12288), 16, 0, 0); } while (0)
  const int nkt = nkeys >> 6;
  __syncthreads();
  ATT_ISSUE(0);
  ATT_ISSUE(1);
  ATT_ISSUE(2);
#pragma unroll 4
  for (int kt = 0; kt < nkt; ++kt) {
    if (kt + 2 < nkt) WAIT_V(8);
    else if (kt + 1 < nkt) WAIT_V(4);
    else WAIT_V(0);
    RAW_BARRIER();
    const char* sK = smem + (kt & 3) * 16384;
    const char* sV = sK + 8192;
#pragma unroll
    for (int m = 0; m < 2; ++m) {
      f32x4 S[NQT][4];
#pragma unroll
      for (int k4 = 0; k4 < 4; ++k4) {
        bf16x8 kf = *(const bf16x8*)(sK + k4 * 2048 + (kb0 ^ (m << 6)));
#pragma unroll
        for (int qt = 0; qt < NQT; ++qt) S[qt][k4] = mfma16(kf, Q[m][qt], f32x4{0.f, 0.f, 0.f, 0.f});
      }

      bf16x8 P[NQT][2];
#pragma unroll
      for (int qt = 0; qt < NQT; ++qt) {
        const float mref = Mx[m][qt];
#pragma unroll
        for (int k4 = 0; k4 < 4; ++k4) {
          f32x4 a4 = S[qt][k4] * cexp - mref;
#pragma unroll
          for (int e = 0; e < 4; ++e) S[qt][k4][e] = fexp2(a4[e]);
        }
#pragma unroll
        for (int ks = 0; ks < 2; ++ks) {
          u32x4 pu = {pack2(S[qt][2 * ks][0], S[qt][2 * ks][1]), pack2(S[qt][2 * ks][2], S[qt][2 * ks][3]),
                      pack2(S[qt][2 * ks + 1][0], S[qt][2 * ks + 1][1]), pack2(S[qt][2 * ks + 1][2], S[qt][2 * ks + 1][3])};
          P[qt][ks] = __builtin_bit_cast(bf16x8, pu);
        }
      }
      if (m == 0 && kt + 3 < nkt) ATT_ISSUE(kt + 3);
#pragma unroll
      for (int ks = 0; ks < 2; ++ks)
#pragma unroll
        for (int qt = 0; qt < NQT; ++qt) Ls[m][qt] = mfma16(ones, P[qt][ks], Ls[m][qt]);
#pragma unroll
      for (int dt = 0; dt < 4; ++dt)
#pragma unroll
        for (int ks = 0; ks < 2; ++ks) {
          bf16x8 vf = ld_vfrag(sV, vb, dt, ks);
#pragma unroll
          for (int qt = 0; qt < NQT; ++qt) O[m][qt][dt] = mfma16(vf, P[qt][ks], O[m][qt][dt]);
        }
    }
  }
#undef ATT_ISSUE
  const float* sub = p.subln_a + j * 64 + opq;
#pragma unroll
  for (int qt = 0; qt < NQT; ++qt) {
    float l0 = Ls[0][qt][0], l1 = Ls[1][qt][0];
    float i0 = 1.f / l0, i1 = lam / l1;
    float ss = 0.f;
    f32x4 o[4];
#pragma unroll
    for (int dt = 0; dt < 4; ++dt) {
#pragma unroll
      for (int e = 0; e < 4; ++e) {
        float v = O[0][qt][dt][e] * i0 - O[1][qt][dt][e] * i1;
        o[dt][e] = v;
        ss += v * v;
      }
    }
    ss += __shfl_xor(ss, 16); ss += __shfl_xor(ss, 32);
    float rstd = rsqrtf(ss * (1.f / 64.f) + EPS) * one_m_li;
    long m = rowbase + q0 + wave * (16 * NQT) + qt * 16 + lr;
#pragma unroll
    for (int dt = 0; dt < 4; ++dt) {
      int d = dt * 16 + 4 * lg;
      u32x2 gg = *(const u32x2*)(PX + m * pitch + 1024 + h * 64 + d);
      f32x4 sw = *(const f32x4*)(sub + d);
      float g0 = bf2f(gg.x & 0xffff), g1 = bf2f(gg.x >> 16), g2 = bf2f(gg.y & 0xffff), g3 = bf2f(gg.y >> 16);
      float r0 = o[dt][0] * rstd * sw.x * silu_f(g0);
      float r1 = o[dt][1] * rstd * sw.y * silu_f(g1);
      float r2 = o[dt][2] * rstd * sw.z * silu_f(g2);
      float r3 = o[dt][3] * rstd * sw.w * silu_f(g3);
      u32x2 ov = {pack2(r0, r1), pack2(r2, r3)};
      *(u32x2*)(MX + blk(m, h * 64 + d, 16)) = ov;
    }
  }
}

__device__ __forceinline__ void conv_item(const Params& p, int l, int item) {
  const int t = VTID;
  const int j = l >> 1;
  const u16* PX = (const u16*)(p.ws + OFF_PX);
  u16* MX = (u16*)(p.ws + OFF_H);
  const int pitch = 3584;
  const int col = (t & 63) * 8, rsub = t >> 6;
  float w0[8], w1[8], w2[8];
  int opq = 0;
  asm volatile("" : "+s"(opq));
  const float* cw = p.conv_b + j * 3 * 512 + opq;
#pragma unroll
  for (int e = 0; e < 8; ++e) { w0[e] = cw[col + e]; w1[e] = cw[512 + col + e]; w2[e] = cw[1024 + col + e]; }
  for (int ps = 0; ps < 8; ++ps) {
    long m = (long)item * 32 + ps * 4 + rsub;
    int w = (int)(m % TPB);
    bool hp = (w != 0) && (w != 256), hn = (w != 255) && (w != TPB - 1);
    const u16* row = PX + m * pitch;
    u32x4 zero = {0, 0, 0, 0};
    u32x4 c1 = *(const u32x4*)(row + 2048 + col), u1 = *(const u32x4*)(row + 2560 + col);
    u32x4 c0 = hp ? *(const u32x4*)(row - pitch + 2048 + col) : zero, u0 = hp ? *(const u32x4*)(row - pitch + 2560 + col) : zero;
    u32x4 c2 = hn ? *(const u32x4*)(row + pitch + 2048 + col) : zero, u2 = hn ? *(const u32x4*)(row + pitch + 2560 + col) : zero;
    u32x4 bb = *(const u32x4*)(row + 1536 + col), gb = *(const u32x4*)(row + 3072 + col);
    const unsigned* pc0 = (const unsigned*)&c0; const unsigned* pu0 = (const unsigned*)&u0;
    const unsigned* pc1 = (const unsigned*)&c1; const unsigned* pu1 = (const unsigned*)&u1;
    const unsigned* pc2 = (const unsigned*)&c2; const unsigned* pu2 = (const unsigned*)&u2;
    const unsigned* pb = (const unsigned*)&bb; const unsigned* pg = (const unsigned*)&gb;
    float r[8];
#pragma unroll
    for (int e = 0; e < 8; ++e) {
      int sh = (e & 1) * 16, q = e >> 1;
      float z0 = bf2f((pc0[q] >> sh) & 0xffff) * bf2f((pu0[q] >> sh) & 0xffff);
      float z1 = bf2f((pc1[q] >> sh) & 0xffff) * bf2f((pu1[q] >> sh) & 0xffff);
      float z2 = bf2f((pc2[q] >> sh) & 0xffff) * bf2f((pu2[q] >> sh) & 0xffff);
      float y = z0 * w0[e] + z1 * w1[e] + z2 * w2[e];
      r[e] = bf2f((pb[q] >> sh) & 0xffff) * y * silu_f(bf2f((pg[q] >> sh) & 0xffff));
    }
    u32x4 o = {pack2(r[0], r[1]), pack2(r[2], r[3]), pack2(r[4], r[5]), pack2(r[6], r[7])};
    *(u32x4*)(MX + blk(m, 512 + col, 16)) = o;
  }
}

__device__ __forceinline__ void phase_mix_even(const Params& p, int l, char* smem) {
  const int QB = 64 * NQT;
  const int NQB = 4096 / QB, NCB = 256 / QB;
  const int N_ATT = 64 * NQB, N_CATT = 64 * NCB, N_CONV = MTOT / 32;
  for (int it = VBLK; it < N_ATT + N_CATT; it += VGRID) {
    int id = it;
    int b, h, q0, nkeys;
    if (id < N_ATT) { int bh = id / NQB; b = bh >> 3; h = bh & 7; q0 = 256 + (id % NQB) * QB; nkeys = TPB; }
    else { id -= N_ATT; int bh = id / NCB; b = bh >> 3; h = bh & 7; q0 = (id % NCB) * QB; nkeys = 256; }
    diff_attn_item(p, l, b, h, q0, nkeys, smem);
  }
  for (int it = (VBLK + VGRID - (N_CATT % VGRID)) % VGRID; it < N_CONV; it += VGRID) conv_item(p, l, it);
}

#define NQR 2
__device__ __forceinline__ void na_item(const Params& p, int l, int b, int h, int rg, bool win, char* smem) {
  const int t = VTID, lane = t & 63, wave = t >> 6, lr = lane & 15, lg = lane >> 4;
  const int j = l >> 1;
  const u16* PX = (const u16*)(p.ws + OFF_PX);
  const u16* VT = (const u16*)(p.ws + OFF_VT);
  u16* MX = (u16*)(p.ws + OFF_H);
  const int pitch = 2048;
  const float cexp = 0.125f * LOG2E;
  const int kx = (lr >> 1) & 7;
  const int kb0 = lr * 128 + ((lg ^ kx) << 4);
  const int vb = kb0;
  const long rowbase = (long)b * TPB;
  const int r0 = rg * NQR;
  const int ulo = win ? min(max(r0 - 4, 0), 56) : 0;
  const int nU = win ? (min(max(r0 + NQR - 5, 0), 56) + 7 - ulo + 1) : 0;
  const int ntile = nU + 4;
  int opq = 0;
  asm volatile("" : "+s"(opq));
  smem += opq;
  __syncthreads();
  const float* BT = (const float*)(p.ws + OFF_BT) + ((long)(j * 8 + h) * 15 * 256 + t) * 16;
  bf16x8 Q[NQR][2];
  const long mrow0 = rowbase + (win ? 256 : 0) + r0 * 64 + wave * 16 + lr;
#pragma unroll
  for (int qr = 0; qr < NQR; ++qr) {
#pragma unroll
    for (int ks = 0; ks < 2; ++ks) Q[qr][ks] = *(const bf16x8*)(PX + (mrow0 + 64 * qr) * pitch + h * 64 + ks * 32 + lg * 8);
  }
  f32x4 O[NQR][4], Ls[NQR];
  float Mx[NQR];
#pragma unroll
  for (int qr = 0; qr < NQR; ++qr) {
    Mx[qr] = -1e30f; Ls[qr] = f32x4{0.f, 0.f, 0.f, 0.f};
#pragma unroll
    for (int dt = 0; dt < 4; ++dt) O[qr][dt] = f32x4{0.f, 0.f, 0.f, 0.f};
  }
  const u32x4 ones_u = {0x3F803F80u, 0x3F803F80u, 0x3F803F80u, 0x3F803F80u};
  const bf16x8 ones = __builtin_bit_cast(bf16x8, ones_u);
  const u16* kbase = PX + rowbase * pitch + 512 + h * 64;
  const u16* vbase = VT + (long)((b * 8 + h) * 64) * TPB;
  auto keybase = [&](int tt) { return tt < nU ? 256 + (ulo + tt) * 64 : (tt - nU) * 64; };
  u32x4 rk[2], rv[2];
  {
    int kb = keybase(0);
    ld_tile64(kbase + (long)kb * pitch, pitch, rk);
    ld_tile64(vbase + kb, TPB, rv);
  }
  st_tile64(smem, rk);
  st_tile64(smem + 8192, rv);
  __syncthreads();
  const int qc = wave * 16 + lr;
  const int cs = min(max(qc - 8, 0), 48);
  const int k4lo = max(wave - 1, 0), k4hi = min(wave + 1, 3);
  for (int tt = 0; tt < NQR + 11; ++tt) {
    if (tt >= ntile) { __syncthreads(); continue; }
    const char* sK = smem + (tt & 1) * 16384;
    const char* sV = sK + 8192;
    if (tt + 1 < ntile) {
      int kb = keybase(tt + 1);
      ld_tile64(kbase + (long)kb * pitch, pitch, rk);
      ld_tile64(vbase + kb, TPB, rv);
    }
    const bool wt = tt < nU;
    const int u = ulo + tt;
#pragma unroll
    for (int qr = 0; qr < NQR; ++qr) {
      const int r = r0 + qr;
      const int rs = min(max(r - 4, 0), 56);
      if (wt && (u < rs || u > rs + 7)) continue;
      f32x4 S[4];
#pragma unroll
      for (int k4 = 0; k4 < 4; ++k4) {
        if (!wt || (k4 >= k4lo && k4 <= k4hi)) {
          S[k4] = mfma16(*(const bf16x8*)(sK + k4 * 2048 + kb0), Q[qr][0], f32x4{0.f, 0.f, 0.f, 0.f});
          S[k4] = mfma16(*(const bf16x8*)(sK + k4 * 2048 + (kb0 ^ 64)), Q[qr][1], S[k4]);
        } else {
          S[k4] = f32x4{-1e30f, -1e30f, -1e30f, -1e30f};
        }
      }
      if (wt) {
        const int roff = u - r + 7;
        const f32x4* bt = (const f32x4*)(BT + roff * 4096);
#pragma unroll
        for (int k4 = 0; k4 < 4; ++k4) {
          if (k4 >= k4lo && k4 <= k4hi) S[k4] = S[k4] * cexp + bt[k4];
        }
      } else {
#pragma unroll
        for (int k4 = 0; k4 < 4; ++k4) S[k4] *= cexp;
      }
      float mx = fmaxf(fmaxf(S[0][0], S[0][1]), fmaxf(S[0][2], S[0][3]));
#pragma unroll
      for (int k4 = 1; k4 < 4; ++k4) mx = fmaxf(fmaxf(mx, S[k4][0]), fmaxf(fmaxf(S[k4][1], S[k4][2]), S[k4][3]));
      if (__builtin_amdgcn_ballot_w64(mx > Mx[qr] + 8.f) != 0) {
        mx = fmaxf(mx, __shfl_xor(mx, 16));
        mx = fmaxf(mx, __shfl_xor(mx, 32));
        float mnew = fmaxf(Mx[qr], mx);
        float alpha = fexp2(Mx[qr] - mnew);
        Mx[qr] = mnew;
#pragma unroll
        for (int dt = 0; dt < 4; ++dt) O[qr][dt] *= alpha;
        Ls[qr] *= alpha;
      }
      const float mref = Mx[qr];
#pragma unroll
      for (int k4 = 0; k4 < 4; ++k4)
#pragma unroll
        for (int e = 0; e < 4; ++e) S[k4][e] = fexp2(S[k4][e] - mref);
#pragma unroll
      for (int ks = 0; ks < 2; ++ks) {
        u32x4 pu = {pack2(S[2 * ks][0], S[2 * ks][1]), pack2(S[2 * ks][2], S[2 * ks][3]),
                    pack2(S[2 * ks + 1][0], S[2 * ks + 1][1]), pack2(S[2 * ks + 1][2], S[2 * ks + 1][3])};
        bf16x8 pf = __builtin_bit_cast(bf16x8, pu);
        Ls[qr] = mfma16(ones, pf, Ls[qr]);
#pragma unroll
        for (int dt = 0; dt < 4; ++dt) O[qr][dt] = mfma16(ld_vfrag(sV, vb, dt, ks), pf, O[qr][dt]);
      }
    }
    if (tt + 1 < ntile) {
      char* ns = smem + ((tt + 1) & 1) * 16384;
      st_tile64(ns, rk);
      st_tile64(ns + 8192, rv);
    }
    __syncthreads();
  }
#pragma unroll
  for (int qr = 0; qr < NQR; ++qr) {
    float inv = 1.f / Ls[qr][0];
#pragma unroll
    for (int dt = 0; dt < 4; ++dt) {
      int d = dt * 16 + 4 * lg;
      u32x2 gg = *(const u32x2*)(PX + (mrow0 + 64 * qr) * pitch + 1024 + h * 64 + d);
      float g0 = bf2f(gg.x & 0xffff), g1 = bf2f(gg.x >> 16), g2 = bf2f(gg.y & 0xffff), g3 = bf2f(gg.y >> 16);
      u32x2 ov = {pack2(O[qr][dt][0] * inv * silu_f(g0), O[qr][dt][1] * inv * silu_f(g1)),
                  pack2(O[qr][dt][2] * inv * silu_f(g2), O[qr][dt][3] * inv * silu_f(g3))};
      *(u32x2*)(MX + blk(mrow0 + 64 * qr, h * 64 + d, 16)) = ov;
    }
  }
}

__device__ __forceinline__ void fourier_ctx_tile(const Params& p, int b, int nt, char* smem) {
  const int t = threadIdx.x, lane = t & 63, wave = t >> 6;
  const int wr = wave >> 2, wc = wave & 3, lr = lane & 15, lg = lane >> 4;
  const u16* PX = (const u16*)(p.ws + OFF_PX);
  u16* MX = (u16*)(p.ws + OFF_H);
  f32x4 acc[8][4];
  const u16* Ad = (const u16*)(p.ws + OFF_DFTC);
  const u16* Bz = (const u16*)(p.ws + OFF_ZTC);
  const float scale = 1.f / 128.f;
  const long mbase = (long)b * TPB;
  gemm_core<4>(Bz, (long)(b * 512 + nt * 256), Ad, 0, 512, acc, smem);
#pragma unroll
  for (int jj = 0; jj < 4; ++jj) {
    long m = mbase + wc * 64 + jj * 16 + lr;
#pragma unroll
    for (int i = 0; i < 8; ++i) {
      int col = nt * 256 + wr * 128 + i * 16 + 4 * lg;
      u32x2 gg = *(const u32x2*)(PX + m * 2048 + 1536 + col);
      float g0 = bf2f(gg.x & 0xffff), g1 = bf2f(gg.x >> 16), g2 = bf2f(gg.y & 0xffff), g3 = bf2f(gg.y >> 16);
      u32x2 ov = {pack2(acc[i][jj][0] * scale * silu_f(g0), acc[i][jj][1] * scale * silu_f(g1)),
                  pack2(acc[i][jj][2] * scale * silu_f(g2), acc[i][jj][3] * scale * silu_f(g3))};
      *(u32x2*)(MX + blk(m, 512 + col, 16)) = ov;
    }
  }
}

__device__ __forceinline__ void fft_stage1_item(const Params& p, int b, int colp) {
  const int t = VTID, lane = t & 63, wave = t >> 6, lr = lane & 15, lg = lane >> 4;
  const u16* F1 = (const u16*)(p.ws + OFF_FM1);
  const float* TC = (const float*)(p.ws + OFF_TWC);
  const float* TS = (const float*)(p.ws + OFF_TWS);
  u16* TG = (u16*)(p.ws + OFF_TG);
  const int ap = 16 * wave + lr;
  bf16x8 yf[2][4];
#pragma unroll
  for (int rp = 0; rp < 2; ++rp)
#pragma unroll
    for (int ks = 0; ks < 4; ++ks) yf[rp][ks] = *(const bf16x8*)(F1 + (rp * 64 + ap) * 128 + ks * 32 + lg * 8);
  bf16x8 xf[2][4][4];
#pragma unroll
  for (int c = 0; c < 2; ++c) {
    const u16* Z = (const u16*)(p.ws + OFF_ZT) + (long)(b * 512 + colp * 2 + c) * 8192;
#pragma unroll
    for (int i = 0; i < 4; ++i)
#pragma unroll
      for (int ks = 0; ks < 4; ++ks)
        xf[c][i][ks] = *(const bf16x8*)(Z + (ks >> 1) * 4096 + (16 * i + lr) * 64 + (ks & 1) * 32 + lg * 8);
  }
#pragma unroll
  for (int c = 0; c < 2; ++c) {
    const int col = colp * 2 + c;
    u16* dst = TG + ((long)(b * 64 + ap) * 512 + col) * 128;
#pragma unroll
    for (int i = 0; i < 4; ++i) {
      f32x4 tr = f32x4{0.f, 0.f, 0.f, 0.f}, ti = f32x4{0.f, 0.f, 0.f, 0.f};
#pragma unroll
      for (int ks = 0; ks < 4; ++ks) {
        tr = mfma16(xf[c][i][ks], yf[0][ks], tr);
        ti = mfma16(xf[c][i][ks], yf[1][ks], ti);
      }
      int bb0 = 16 * i + 4 * lg;
      f32x4 tc = *(const f32x4*)(TC + ap * 64 + bb0);
      f32x4 ts = *(const f32x4*)(TS + ap * 64 + bb0);
      f32x4 nr = tr * tc + ti * ts;
      f32x4 ni = ti * tc - tr * ts;
      u32x2 o0 = {pack2(nr[0], nr[1]), pack2(nr[2], nr[3])};
      u32x2 o1 = {pack2(ni[0], ni[1]), pack2(ni[2], ni[3])};
      *(u32x2*)(dst + bb0) = o0;
      *(u32x2*)(dst + 64 + bb0) = o1;
    }
  }
}

__device__ __forceinline__ void fft_stage2_item(const Params& p, int b, int ap, int ct) {
  const int t = VTID, lane = t & 63, wave = t >> 6, lr = lane & 15, lg = lane >> 4;
  const u16* T = (const u16*)(p.ws + OFF_TG) + ((long)(b * 64 + ap) * 512 + ct * 128) * 128;
  const u16* F2 = (const u16*)(p.ws + OFF_FM2);
  const u16* PX = (const u16*)(p.ws + OFF_PX);
  u16* MX = (u16*)(p.ws + OFF_H);
  bf16x8 yf[4][4];
#pragma unroll
  for (int jj = 0; jj < 4; ++jj)
#pragma unroll
    for (int ks = 0; ks < 4; ++ks) yf[jj][ks] = *(const bf16x8*)(F2 + (16 * jj + lr) * 128 + ks * 32 + lg * 8);
#pragma unroll
  for (int mi = 0; mi < 2; ++mi) {
    bf16x8 xf[4];
#pragma unroll
    for (int ks = 0; ks < 4; ++ks) xf[ks] = *(const bf16x8*)(T + (wave * 32 + mi * 16 + lr) * 128 + ks * 32 + lg * 8);
#pragma unroll
    for (int jj = 0; jj < 4; ++jj) {
      f32x4 acc = f32x4{0.f, 0.f, 0.f, 0.f};
#pragma unroll
      for (int ks = 0; ks < 4; ++ks) acc = mfma16(xf[ks], yf[jj][ks], acc);
      int bp = 16 * jj + lr;
      long m = (long)b * TPB + 256 + ap + 64 * bp;
      int col = ct * 128 + wave * 32 + mi * 16 + 4 * lg;
      u32x2 gg = *(const u32x2*)(PX + m * 2048 + 1536 + col);
      float g0 = bf2f(gg.x & 0xffff), g1 = bf2f(gg.x >> 16), g2 = bf2f(gg.y & 0xffff), g3 = bf2f(gg.y >> 16);
      const float scale = 1.f / 512.f;
      u32x2 ov = {pack2(acc[0] * scale * silu_f(g0), acc[1] * scale * silu_f(g1)),
                  pack2(acc[2] * scale * silu_f(g2), acc[3] * scale * silu_f(g3))};
      *(u32x2*)(MX + blk(m, 512 + col, 16)) = ov;
    }
  }
}

__device__ __forceinline__ void phase_mix_odd(const Params& p, int l, char* smem) {
  const bool need_ctx = l < 3;
  const int N_F1 = 4096, N_NA = 64 * (64 / NQR), N_CA = need_ctx ? 64 * (4 / NQR) : 0, N_FC = need_ctx ? 16 : 0;
  for (int rep = 0; rep < ((PROBE_DUP & 512) ? 2 : 1); ++rep)
  for (int it = VBLK; it < N_NA + N_CA; it += VGRID) {
    int id = it;
    bool win = id < N_NA;
    int b, h, r;
    if (win) { int bh = id / (64 / NQR); b = bh >> 3; h = bh & 7; r = id % (64 / NQR); }
    else { id -= N_NA; int bh = id / (4 / NQR); b = bh >> 3; h = bh & 7; r = id % (4 / NQR); }
    na_item(p, l, b, h, r, win, smem + VHALF * 65536);
  }
  for (int rep = 0; rep < ((PROBE_DUP & 256) ? 2 : 1); ++rep)
  for (int it = VBLK; it < N_F1 / 2; it += VGRID) fft_stage1_item(p, it >> 8, it & 255);
  for (int it = blockIdx.x; it < N_FC; it += gridDim.x) {
    fourier_ctx_tile(p, it >> 1, it & 1, smem);
  }
}
__device__ __forceinline__ void phase_mix_odd_b(const Params& p) {
  for (int rep = 0; rep < ((PROBE_DUP & 1024) ? 2 : 1); ++rep)
  for (int it = VBLK; it < 2048; it += VGRID) fft_stage2_item(p, it >> 8, (it >> 2) & 63, it & 3);
}

template <int NJ>
__device__ __forceinline__ void out_tile(const Params& p, int l, long row0, int nt, char* smem) {
  const int t = threadIdx.x, lane = t & 63, wave = t >> 6;
  const int wr = wave >> 2, wc = wave & 3, lr = lane & 15, lg = lane >> 4;
  const u16* MX = (const u16*)(p.ws + OFF_H);
  const u16* Wt = (const u16*)(p.ws + OFF_WT_OUT) + (long)l * 1024 * 1024;
  u16* Y = (u16*)(p.ws + OFF_PX);
  float* SSQ = (float*)(p.ws + OFF_SSQ);
  f32x4 acc[8][NJ];
  gemm_core<NJ>(Wt, (long)nt * 256, MX, row0, 1024, acc, smem);
#pragma unroll
  for (int jj = 0; jj < NJ; ++jj) {
    long m = row0 + wc * (16 * NJ) + jj * 16 + lr;
    float ss = 0.f;
#pragma unroll
    for (int i = 0; i < 8; ++i) {
      f32x4 v = acc[i][jj];
      ss += v[0] * v[0] + v[1] * v[1] + v[2] * v[2] + v[3] * v[3];
      u32x2 o = {pack2(v[0], v[1]), pack2(v[2], v[3])};
      *(u32x2*)(Y + m * 1024 + nt * 256 + wr * 128 + i * 16 + 4 * lg) = o;
    }
    ss += __shfl_xor(ss, 16);
    ss += __shfl_xor(ss, 32);
    if (lg == 0) SSQ[m * 16 + nt * 2 + wr] = ss;
  }
}
__device__ __forceinline__ void phase_out(const Params& p, int l, char* smem) {
  for (int it = blockIdx.x; it < 1024; it += gridDim.x) {
    int lt = it >> 2, nt = it & 3;
    int b = lt >> 5, j = lt & 31;
    out_tile<2>(p, l, (long)(b * 34 + 2 + j) * 128, nt, smem);
  }
  if (l < 3) {
    for (int id = blockIdx.x; id < 128; id += gridDim.x) {
      int nt = id & 3, h64 = (id >> 2) & 1, cm = id >> 3;
      int b = cm >> 1;
      out_tile<1>(p, l, (long)(b * 34 + (cm & 1)) * 128 + h64 * 64, nt, smem);
    }
  }
}

#define XB_TMO      128
#define XB_XCNT(j)  (256  + 64 * (j))
#define XB_XSUB(j)  (1280 + 64 * (j))
#define XB_XGEN(j)  (2304 + 64 * (j))
#define XB_TOP      3328
#define XB_TOPGEN   3392
#define XB_PERWG    3456
#define XB_SPIN_CAP (1u << 20)
__device__ __forceinline__ unsigned xb_ld(unsigned* p)              { return __hip_atomic_load(p, __ATOMIC_RELAXED, __HIP_MEMORY_SCOPE_AGENT); }
__device__ __forceinline__ unsigned xb_add(unsigned* p, unsigned v) { return __hip_atomic_fetch_add(p, v, __ATOMIC_RELAXED, __HIP_MEMORY_SCOPE_AGENT); }
__device__ __forceinline__ unsigned xb_xcc_id() { return (unsigned)__builtin_amdgcn_s_getreg((3 << 11) | 20) & 0xFu; }
#define XB_SPIN(cond, bar) do { unsigned _sp = 0; while (cond) { __builtin_amdgcn_s_sleep(1); \
    if ((++_sp & 255u) == 0u) { if (xb_ld(&(bar)[XB_TMO])) break; if (_sp > XB_SPIN_CAP) { atomicAdd(&(bar)[XB_TMO], 1u); break; } } } } while (0)
__device__ __forceinline__ void xcd_barrier_post(unsigned* bar) {
  if (threadIdx.x == 0) (void)xb_add(&bar[XB_XCNT(xb_xcc_id())], 1u);
}
__device__ __forceinline__ void xcd_barrier_complete(unsigned* bar, unsigned x, unsigned& nloc, unsigned& nx) {
  const unsigned G = gridDim.x;
  unsigned sum, cnt, mine, sp = 0u;
  for (;;) {
    sum = 0u; cnt = 0u; mine = 0u;
#pragma unroll
    for (unsigned j = 0; j < 16; ++j) { const unsigned c = xb_ld(&bar[XB_XCNT(j)]); sum += c; cnt += (c > 0u) ? 1u : 0u; mine = (j == x) ? c : mine; }
    if (sum == G) break;
    __builtin_amdgcn_s_sleep(1);
    if ((++sp & 255u) == 0u) { if (xb_ld(&bar[XB_TMO])) break; if (sp > XB_SPIN_CAP) { atomicAdd(&bar[XB_TMO], 1u); break; } }
  }
  nloc = mine > 0u ? mine : 1u; nx = cnt > 0u ? cnt : 1u;
}
__device__ __forceinline__ void xcd_barrier(unsigned* bar) {
  asm volatile("s_waitcnt vmcnt(0)" ::: "memory");
  __syncthreads();
  if (threadIdx.x == 0) {
    __builtin_amdgcn_s_waitcnt(0);
    const unsigned x = xb_xcc_id();
    unsigned* mine = bar + XB_PERWG + 2 * blockIdx.x;
    unsigned nloc = mine[0], nx = mine[1];
    if (nloc == 0u) { xcd_barrier_complete(bar, x, nloc, nx); mine[0] = nloc; mine[1] = nx; }
    const unsigned old = xb_add(&bar[XB_XSUB(x)], 1u);
    const unsigned gen = old / nloc;
    if (old + 1u == (gen + 1u) * nloc) {
      __builtin_amdgcn_fence(__ATOMIC_RELEASE, "agent");
      asm volatile("s_waitcnt vmcnt(0)" ::: "memory");
      const unsigned og = xb_add(&bar[XB_TOP], 1u);
      const unsigned tg = og / nx;
      if (og + 1u == (tg + 1u) * nx) xb_add(&bar[XB_TOPGEN], 1u);
      else XB_SPIN(xb_ld(&bar[XB_TOPGEN]) == tg, bar);
      __builtin_amdgcn_fence(__ATOMIC_ACQUIRE, "agent");
      xb_add(&bar[XB_XGEN(x)], 1u);
      asm volatile("s_waitcnt vmcnt(0)" ::: "memory");
    } else {
      XB_SPIN(xb_ld(&bar[XB_XGEN(x)]) == gen, bar);
      __builtin_amdgcn_fence(__ATOMIC_ACQUIRE, "agent");
      asm volatile("s_waitcnt vmcnt(0)" ::: "memory");
    }
  }
  __syncthreads();
}

#define GSYNC(PH) do { xcd_barrier(bar); } while (0)
#define RUN_PHASE(PH, CALL) if (PH >= ph_lo && PH < ph_hi) { if (PH > ph_lo) GSYNC(PH); CALL; }
#define RUN_PHASE_N(PH, L) if (PROBE_DUP & 2048) { GSYNC(PH); phase_proj<true>(p, L, smem); }
#define RUN_PHASE_D(BIT, PH, CALL) if (PH >= ph_lo && PH < ph_hi) { if (PH > ph_lo) GSYNC(PH); CALL; if (PROBE_DUP & (BIT)) { GSYNC(PH); CALL; } }
__global__ void __launch_bounds__(512, 2) mega(Params p, int ph_lo, int ph_hi) {
  extern __shared__ __attribute__((aligned(16))) char smem[];
  cg::grid_group grid = cg::this_grid();
  char* smh = smem + VHALF * 65536;
  unsigned* bar = (unsigned*)(p.ws + OFF_BAR);
  if (ph_lo < 0) grid.sync();
  xcd_barrier_post(bar);
  RUN_PHASE_D(16, 0, phase_prep(p, smh));
  RUN_PHASE_D(32, 1, phase_rows(p, -1));
  RUN_PHASE_D(1, 2, phase_proj(p, 0, smem));
  RUN_PHASE_N(2, 0);
  RUN_PHASE_D(2, 3, phase_mix_even(p, 0, smh));
  RUN_PHASE_D(8, 4, phase_out(p, 0, smem));
  RUN_PHASE(5, phase_rows(p, 0));
  RUN_PHASE_D(1, 6, phase_proj(p, 1, smem));
  RUN_PHASE_N(6, 1);
  RUN_PHASE_D(4, 7, phase_mix_odd(p, 1, smem));
  RUN_PHASE_D(4, 8, phase_mix_odd_b(p));
  RUN_PHASE_D(8, 9, phase_out(p, 1, smem));
  RUN_PHASE(10, phase_rows(p, 1));
  RUN_PHASE_D(1, 11, phase_proj(p, 2, smem));
  RUN_PHASE_N(11, 2);
  RUN_PHASE_D(2, 12, phase_mix_even(p, 2, smh));
  RUN_PHASE_D(8, 13, phase_out(p, 2, smem));
  RUN_PHASE(14, phase_rows(p, 2));
  RUN_PHASE_D(1, 15, phase_proj(p, 3, smem));
  RUN_PHASE_N(15, 3);
  RUN_PHASE_D(4, 16, phase_mix_odd(p, 3, smem));
  RUN_PHASE_D(4, 17, phase_mix_odd_b(p));
  RUN_PHASE_D(8, 18, phase_out(p, 3, smem));
  RUN_PHASE(19, phase_rows(p, 3));
}

extern "C" void kernel_launch(void* const* d_in, const int* in_sizes, int n_in, void* d_out, int out_size,
                              void* d_ws, size_t ws_size, hipStream_t stream) {
  static int grid_blocks = 0;
  if (!grid_blocks) {
    int dev = 0, cus = 0, per_cu = 0;
    hipGetDevice(&dev);
    hipDeviceGetAttribute(&cus, hipDeviceAttributeMultiprocessorCount, dev);
    hipFuncSetAttribute((const void*)mega, hipFuncAttributeMaxDynamicSharedMemorySize, SMEM_BYTES);
    hipOccupancyMaxActiveBlocksPerMultiprocessor(&per_cu, mega, 512, SMEM_BYTES);
    if (per_cu < 1) per_cu = 1;
    if (per_cu > 1) per_cu = 1;
    grid_blocks = cus * per_cu;
  }
  Params p{};
  p.x = (const float*)d_in[0]; p.c = (const float*)d_in[1]; p.ctx = (const float*)d_in[2]; p.c_ctx = (const float*)d_in[3];
  p.w_mod = (const float*)d_in[4]; p.b_mod = (const float*)d_in[5]; p.norm_pre = (const float*)d_in[6];
  p.norm_post = (const float*)d_in[7]; p.w_in_even = (const float*)d_in[8]; p.lam_a = (const float*)d_in[9];
  p.subln_a = (const float*)d_in[10]; p.conv_b = (const float*)d_in[11]; p.w_in_odd = (const float*)d_in[12];
  p.rpb_c = (const float*)d_in[13]; p.w_out = (const float*)d_in[14];
  p.out = (float*)d_out;
  p.ws = (char*)d_ws;
  if (ws_size < WS_TOTAL) fprintf(stderr, "workspace too small: %zu < %zu\n", ws_size, (size_t)WS_TOTAL);
#if MULTI_LAUNCH
  for (int ph = 0; ph < NPHASE; ++ph) {
    hipLaunchKernelGGL(mega, dim3(grid_blocks), dim3(512), SMEM_BYTES, stream, p, ph, ph + 1);
  }
#else
  int lo = 0, hi = NPHASE;
  void* args[] = {&p, &lo, &hi};
  hipMemsetAsync((char*)d_ws + OFF_BAR, 0, BAR_BYTES, stream);
  hipError_t e = hipLaunchCooperativeKernel((void*)mega, dim3(grid_blocks), dim3(512), args, SMEM_BYTES, stream);
  if (e != hipSuccess) fprintf(stderr, "cooperative launch failed: %s (grid %d)\n", hipGetErrorString(e), grid_blocks);
#endif
}
```
